# Optimizing an MI355X kernel written in HIP

```python
import jax, jax.numpy as jnp
from jax import lax
import numpy as np

D_MODEL = 1024
BATCH = 8
SEQ = 4096
DEPTH = 2

GRID_W = 64
CTX_LEN = 256
EPS = 1e-6
N_MOD = 9
D_FF = 2816
BRANCH_W = 512
N_BRANCH = 3
MLA_HEADS = 8
MLA_Q_RANK = 256
MLA_KV_RANK = 128
MLA_NOPE = 64
MLA_ROPE = 32
MLA_V = 64
MLA_QK = MLA_NOPE + MLA_ROPE
AXIS_DIM = MLA_ROPE // 2
ROPE_THETA = 10000.0
Q_BLOCK = 128
POOL_WINDOWS = (2, 4, 8, 16)
POOL_GROUPS = len(POOL_WINDOWS)
POOL_GDIM = BRANCH_W // POOL_GROUPS
GLA_HEADS = 4
GLA_DK = 64
GLA_DV = 128
GLA_GATE_RANK = 16
GLA_TAU = 16.0
GLA_CHUNK = 64
IN_SPLITS = (MLA_Q_RANK, MLA_KV_RANK, MLA_ROPE,
             BRANCH_W,
             GLA_HEADS * GLA_DK, GLA_HEADS * GLA_DK,
             GLA_HEADS * GLA_DV,
             2 * GLA_GATE_RANK,
             GLA_HEADS * GLA_DV,
             N_BRANCH * D_MODEL)
D_IN = sum(IN_SPLITS)

kernel_name = "hybrid_mla_pool_gla_macaron_dit"

F32 = jnp.float32


def rmsnorm(x, g):
    xf = x.astype(F32)
    y = xf * lax.rsqrt(jnp.mean(xf * xf, axis=-1, keepdims=True) + EPS)
    return (y * g.astype(F32)).astype(x.dtype)


def modulate(x, shift, scale):
    return x * (1 + scale) + shift


def ffn_half_step(h, g, shift, scale, gate, w1, w3, w2):
    u = modulate(rmsnorm(h, g), shift, scale)
    return h + 0.5 * gate * ((jax.nn.silu(u @ w1) * (u @ w3)) @ w2)


def split_cols(z):
    idx = [int(i) for i in np.cumsum(IN_SPLITS)[:-1]]
    return jnp.split(z, idx, axis=-1)


def rope_tables(L):
    rows = L // GRID_W
    r, col = jnp.meshgrid(jnp.arange(rows, dtype=F32), jnp.arange(GRID_W, dtype=F32), indexing="ij")
    inv = ROPE_THETA ** (-jnp.arange(0, AXIS_DIM, 2, dtype=F32) / AXIS_DIM)
    pos = jnp.stack([r.reshape(-1), col.reshape(-1)], axis=-1)
    ang = pos[:, :, None] * inv
    return jnp.cos(ang), jnp.sin(ang)


def apply_rope2d(x, cos, sin):
    shp = x.shape
    xf = x.astype(F32).reshape(shp[:-1] + (2, 2, AXIS_DIM // 2))
    bshape = (shp[1],) + (1,) * (x.ndim - 3) + (2, AXIS_DIM // 2)
    cs, sn = cos.reshape(bshape), sin.reshape(bshape)
    x1, x2 = xf[..., 0, :], xf[..., 1, :]
    out = jnp.stack([x1 * cs - x2 * sn, x2 * cs + x1 * sn], axis=-2)
    return out.reshape(shp).astype(x.dtype)


def mla_project(cq, ckv, kr, g_cq, w_uq, g_ckv, w_ukv, g_qn, g_kn, rope):
    B, L = cq.shape[:2]
    q = (rmsnorm(cq, g_cq) @ w_uq).reshape(B, L, MLA_HEADS, MLA_QK)
    kv = (rmsnorm(ckv, g_ckv) @ w_ukv).reshape(B, L, MLA_HEADS, MLA_NOPE + MLA_V)
    k = jnp.concatenate([kv[..., :MLA_NOPE],
                         jnp.broadcast_to(kr[:, :, None, :], (B, L, MLA_HEADS, MLA_ROPE))], axis=-1)
    q, k = rmsnorm(q, g_qn), rmsnorm(k, g_kn)
    if rope is not None:
        cos, sin = rope
        q = jnp.concatenate([q[..., :MLA_NOPE], apply_rope2d(q[..., MLA_NOPE:], cos, sin)], axis=-1)
        k = jnp.concatenate([k[..., :MLA_NOPE], apply_rope2d(k[..., MLA_NOPE:], cos, sin)], axis=-1)
    return q, k, kv[..., MLA_NOPE:]


def attend(q, k, v):
    s = jnp.einsum("bqhd,bkhd->bhqk", q.astype(F32), k.astype(F32)) * (MLA_QK ** -0.5)
    p = jax.nn.softmax(s, axis=-1)
    return jnp.einsum("bhqk,bkhd->bqhd", p, v.astype(F32)).astype(v.dtype)


def blocked_attend(q, k, v):
    B, L, H, Dq = q.shape
    nb = L // Q_BLOCK
    qb = q.reshape(B, nb, Q_BLOCK, H, Dq).transpose(1, 0, 2, 3, 4)
    out = lax.map(lambda qi: attend(qi, k, v), qb)
    return out.transpose(1, 0, 2, 3, 4).reshape(B, L, H, v.shape[-1])


def multiscale_pool(p, w_pool, pool_scale):
    B, L, _ = p.shape
    pf = p.astype(F32)
    S = jnp.concatenate([jnp.zeros((B, 1, BRANCH_W), F32), jnp.cumsum(pf, axis=1)], axis=1)
    t = jnp.arange(L)
    outs = []
    for g, w in enumerate(POOL_WINDOWS):
        lo = jnp.clip(t - w // 2, 0, L)
        hi = jnp.clip(t + w // 2, 0, L)
        sl = slice(g * POOL_GDIM, (g + 1) * POOL_GDIM)
        Sg = S[..., sl]
        mean = (Sg[:, hi] - Sg[:, lo]) / (hi - lo).astype(F32)[None, :, None]
        outs.append(mean - pf[..., sl])
    pooled = jnp.stack(outs, axis=2).astype(p.dtype)
    y = jnp.einsum("blgc,gcd->blgd", pooled, w_pool).reshape(B, L, BRANCH_W)
    return y * pool_scale


def gla_prepare(q, k, v, a_lr, w_a2, b_a2):
    B, L = q.shape[:2]
    qh = q.astype(F32).reshape(B, L, GLA_HEADS, GLA_DK) * (GLA_DK ** -0.5)
    kh = k.astype(F32).reshape(B, L, GLA_HEADS, GLA_DK)
    vh = v.astype(F32).reshape(B, L, GLA_HEADS, GLA_DV)
    logit = jnp.einsum("bldr,drk->bldk", a_lr.reshape(B, L, 2, GLA_GATE_RANK), w_a2) + b_a2
    log_a = (jax.nn.log_sigmoid(logit.astype(F32)) / GLA_TAU).reshape(B, L, 2, GLA_HEADS, GLA_DK)
    return qh, kh, vh, log_a


def gla_chunk_scan(q, k, v, log_a, s0):
    B, L, H, DK = q.shape
    DV = v.shape[-1]
    N, C = L // GLA_CHUNK, GLA_CHUNK

    def chunks(t):
        return t.reshape(B, N, C, H, t.shape[-1]).transpose(0, 3, 1, 2, 4)

    qc, kc, vc, ac = chunks(q), chunks(k), chunks(v), chunks(log_a)
    b = jnp.cumsum(ac, axis=3)
    b_last = b[:, :, :, -1:, :]
    q_t = qc * jnp.exp(b)
    k_t = kc * jnp.exp(-b)
    k_end = kc * jnp.exp(b_last - b)
    mask = jnp.tril(jnp.ones((C, C), dtype=bool))
    A = jnp.where(mask, jnp.einsum("bhnik,bhnjk->bhnij", q_t, k_t), 0.0)
    o_intra = jnp.einsum("bhnij,bhnjv->bhniv", A, vc)
    dS = jnp.einsum("bhnjk,bhnjv->nbhkv", k_end, vc)
    decay = jnp.exp(b_last[:, :, :, 0, :]).transpose(2, 0, 1, 3)

    def step(S, inp):
        d, ds = inp
        return d[..., None] * S + ds, S

    s_final, s_starts = lax.scan(step, s0, (decay, dS))
    o_inter = jnp.einsum("bhnik,nbhkv->bhniv", q_t, s_starts)
    o = (o_intra + o_inter).transpose(0, 2, 3, 1, 4).reshape(B, L, H, DV)
    return o, s_final


def gla_bidir(q, k, v, log_a, s0_f, s0_b):
    o_f, s_f = gla_chunk_scan(q, k, v, log_a[:, :, 0], s0_f)
    fl = lambda t: jnp.flip(t, axis=1)
    o_b, s_b = gla_chunk_scan(fl(q), fl(k), fl(v), fl(log_a[:, :, 1]), s0_b)
    return o_f + fl(o_b), s_f, s_b


def gla_output(o, r, g):
    B, L = o.shape[:2]
    on = rmsnorm(o, g).reshape(B, L, GLA_HEADS * GLA_DV).astype(r.dtype)
    return on * jax.nn.silu(r)


def merge_branches(gates, o_a, o_p, o_g, w_branch, w_out):
    B, L = gates.shape[:2]
    g = jax.nn.sigmoid(gates.astype(F32)).astype(gates.dtype).reshape(B, L, N_BRANCH, D_MODEL)
    m = (g[:, :, 0] * (o_a @ w_branch[0])
         + g[:, :, 1] * (o_p @ w_branch[1])
         + g[:, :, 2] * (o_g @ w_branch[2]))
    return m @ w_out


def token_mixer(u, uc, rope, w_in, g_cq, w_uq, g_ckv, w_ukv, g_qn, g_kn, w_pool, pool_scale,
                w_a2, b_a2, g_gla_o, w_branch, w_out, need_ctx):
    B, L, _ = u.shape
    cq, ckv, kr, pz, gq, gk, gv, ga, gr, gates = split_cols(u @ w_in)
    cq_c, ckv_c, kr_c, pz_c, gq_c, gk_c, gv_c, ga_c, gr_c, gates_c = split_cols(uc @ w_in)
    q, k, v = mla_project(cq, ckv, kr, g_cq, w_uq, g_ckv, w_ukv, g_qn, g_kn, rope)
    q_c, k_c, v_c = mla_project(cq_c, ckv_c, kr_c, g_cq, w_uq, g_ckv, w_ukv, g_qn, g_kn, None)
    k_all = jnp.concatenate([k_c, k], axis=1)
    v_all = jnp.concatenate([v_c, v], axis=1)
    o_a = blocked_attend(q, k_all, v_all).reshape(B, L, MLA_HEADS * MLA_V)
    o_p = multiscale_pool(pz, w_pool, pool_scale)
    qg, kg, vg, la = gla_prepare(gq, gk, gv, ga, w_a2, b_a2)
    qg_c, kg_c, vg_c, la_c = gla_prepare(gq_c, gk_c, gv_c, ga_c, w_a2, b_a2)
    s0 = jnp.zeros((uc.shape[0], GLA_HEADS, GLA_DK, GLA_DV), F32)
    og_c, s_f, s_b = gla_bidir(qg_c, kg_c, vg_c, la_c, s0, s0)
    og, _, _ = gla_bidir(qg, kg, vg, la, s_f, s_b)
    o_g = gla_output(og, gr, g_gla_o)
    y = merge_branches(gates, o_a, o_p, o_g, w_branch, w_out)
    if not need_ctx:
        return y, None
    Lc = uc.shape[1]
    o_a_c = attend(q_c, k_c, v_c).reshape(uc.shape[0], Lc, MLA_HEADS * MLA_V)
    o_p_c = multiscale_pool(pz_c, w_pool, pool_scale)
    o_g_c = gla_output(og_c, gr_c, g_gla_o)
    yc = merge_branches(gates_c, o_a_c, o_p_c, o_g_c, w_branch, w_out)
    return y, yc


def setup_inputs(seed: int = 0) -> dict:
    key = jax.random.key(seed)
    it = iter(jax.random.split(key, 40))

    def nrm(shape, scale):
        return jax.random.normal(next(it), shape, F32) * scale

    def gain(shape):
        return 1.0 + 0.1 * jax.random.normal(next(it), shape, F32)

    D = D_MODEL
    return {
        "x": nrm((BATCH, SEQ, D), 1.0),
        "c": nrm((BATCH, D), 1.0),
        "ctx": nrm((BATCH, CTX_LEN, D), 1.0),
        "c_ctx": nrm((D,), 1.0),
        "w_ada": nrm((DEPTH, D, N_MOD * D), 0.5 * D ** -0.5),
        "b_ada": nrm((DEPTH, N_MOD * D), 0.02),
        "g_ffn1": gain((DEPTH, D)),
        "ffn1_w1": nrm((DEPTH, D, D_FF), D ** -0.5),
        "ffn1_w3": nrm((DEPTH, D, D_FF), D ** -0.5),
        "ffn1_w2": nrm((DEPTH, D_FF, D), D_FF ** -0.5),
        "g_mix": gain((DEPTH, D)),
        "w_in": nrm((DEPTH, D, D_IN), D ** -0.5),
        "g_cq": gain((DEPTH, MLA_Q_RANK)),
        "w_uq": nrm((DEPTH, MLA_Q_RANK, MLA_HEADS * MLA_QK), MLA_Q_RANK ** -0.5),
        "g_ckv": gain((DEPTH, MLA_KV_RANK)),
        "w_ukv": nrm((DEPTH, MLA_KV_RANK, MLA_HEADS * (MLA_NOPE + MLA_V)), MLA_KV_RANK ** -0.5),
        "g_qn": gain((DEPTH, MLA_QK)),
        "g_kn": gain((DEPTH, MLA_QK)),
        "w_pool": nrm((DEPTH, POOL_GROUPS, POOL_GDIM, POOL_GDIM), POOL_GDIM ** -0.5),
        "pool_scale": gain((DEPTH, BRANCH_W)),
        "w_a2": nrm((DEPTH, 2, GLA_GATE_RANK, GLA_HEADS * GLA_DK), GLA_GATE_RANK ** -0.5),
        "b_a2": nrm((DEPTH, 2, GLA_HEADS * GLA_DK), 0.5),
        "g_gla_o": gain((DEPTH, GLA_DV)),
        "w_branch": nrm((DEPTH, N_BRANCH, BRANCH_W, D), BRANCH_W ** -0.5),
        "w_out": nrm((DEPTH, D, D), D ** -0.5),
        "g_ffn2": gain((DEPTH, D)),
        "ffn2_w1": nrm((DEPTH, D, D_FF), D ** -0.5),
        "ffn2_w3": nrm((DEPTH, D, D_FF), D ** -0.5),
        "ffn2_w2": nrm((DEPTH, D_FF, D), D_FF ** -0.5),
    }


def reference(x, c, ctx, c_ctx, w_ada, b_ada, g_ffn1, ffn1_w1, ffn1_w3, ffn1_w2, g_mix, w_in,
              g_cq, w_uq, g_ckv, w_ukv, g_qn, g_kn, w_pool, pool_scale, w_a2, b_a2, g_gla_o,
              w_branch, w_out, g_ffn2, ffn2_w1, ffn2_w3, ffn2_w2):
    B, L, D = x.shape
    rope = rope_tables(L)
    h, hc = x, ctx
    sc, scc = jax.nn.silu(c), jax.nn.silu(c_ctx)
    for l in range(DEPTH):
        last = l == DEPTH - 1
        mod = (sc @ w_ada[l] + b_ada[l]).reshape(B, 1, N_MOD, D)
        mod_c = (scc @ w_ada[l] + b_ada[l]).reshape(1, 1, N_MOD, D)
        h = ffn_half_step(h, g_ffn1[l], mod[:, :, 0], mod[:, :, 1], mod[:, :, 2],
                          ffn1_w1[l], ffn1_w3[l], ffn1_w2[l])
        hc = ffn_half_step(hc, g_ffn1[l], mod_c[:, :, 0], mod_c[:, :, 1], mod_c[:, :, 2],
                           ffn1_w1[l], ffn1_w3[l], ffn1_w2[l])
        u = modulate(rmsnorm(h, g_mix[l]), mod[:, :, 3], mod[:, :, 4])
        uc = modulate(rmsnorm(hc, g_mix[l]), mod_c[:, :, 3], mod_c[:, :, 4])
        y, yc = token_mixer(u, uc, rope, w_in[l], g_cq[l], w_uq[l], g_ckv[l], w_ukv[l], g_qn[l],
                            g_kn[l], w_pool[l], pool_scale[l], w_a2[l], b_a2[l], g_gla_o[l],
                            w_branch[l], w_out[l], not last)
        h = h + mod[:, :, 5] * y
        h = ffn_half_step(h, g_ffn2[l], mod[:, :, 6], mod[:, :, 7], mod[:, :, 8],
                          ffn2_w1[l], ffn2_w3[l], ffn2_w2[l])
        if not last:
            hc = hc + mod_c[:, :, 5] * yc
            hc = ffn_half_step(hc, g_ffn2[l], mod_c[:, :, 6], mod_c[:, :, 7], mod_c[:, :, 8],
                               ffn2_w1[l], ffn2_w3[l], ffn2_w2[l])
    return h
```

```cpp
#include <hip/hip_runtime.h>
#include <hip/hip_cooperative_groups.h>
#include <cstdio>
#include <cstdint>
namespace cg = cooperative_groups;

#define DI __device__ __forceinline__
#define LAS __attribute__((address_space(3)))
typedef unsigned short bf16_t;
typedef short bf16x8 __attribute__((ext_vector_type(8)));
typedef short s16x4 __attribute__((ext_vector_type(4)));
typedef float f32x4 __attribute__((ext_vector_type(4)));
typedef float f32x16 __attribute__((ext_vector_type(16)));
typedef unsigned u32x4 __attribute__((ext_vector_type(4)));
typedef unsigned u32x2 __attribute__((ext_vector_type(2)));
typedef float f32x2_t __attribute__((ext_vector_type(2)));
typedef __bf16 bf16x2_t __attribute__((ext_vector_type(2)));

constexpr int D = 1024, NB = 8, SEQ = 4096, LC = 256, ML = NB * SEQ, MC = NB * LC, M = ML + MC;
constexpr int DFF = 2816, DIN = 5568, NMOD = 9;
constexpr int KVLEN = LC + SEQ;
constexpr int ZR = 2304;
constexpr int NSLOT = 68;
constexpr float EPS = 1e-6f;
constexpr float C2 = 0.10206207261596577f * 1.4426950408889634f;

constexpr size_t MiB = 1u << 20;
constexpr size_t WS_ROPE = 0;
constexpr size_t WS_BAR = 768 * 1024;
constexpr size_t WS_MOD = 1 * MiB;
constexpr size_t WS_HC = 2 * MiB;
constexpr size_t WS_U = 10 * MiB;
constexpr size_t WS_W = 78 * MiB;
constexpr size_t W_13A = 0, W_2A = 11 * MiB, W_13B = W_2A + 5767168, W_2B = W_13B + 11 * MiB, W_IN = W_2B + 5767168;
constexpr size_t W_UQ = W_IN + (size_t)5888 * 1024 * 2, W_UKV = W_UQ + 768 * 256 * 2, W_POOL = W_UKV + 1024 * 256 * 2;
constexpr size_t W_BR = W_POOL + 512 * 512 * 2, W_OUT = W_BR + (size_t)3 * 1024 * 512 * 2, W_END = W_OUT + 1024 * 1024 * 2;
static_assert(W_END <= 52 * MiB, "weights");
constexpr size_t AR = 130 * MiB;
constexpr size_t A_G = AR;
constexpr size_t A_OA = AR, A_OP = AR + 34 * MiB, A_OG = AR + 68 * MiB;
constexpr size_t A_ZCQ = AR + 34 * MiB, A_ZKV = AR + 51 * MiB, A_QRAW = AR + 68 * MiB, A_KVRAW = AR + 119 * MiB;
constexpr size_t A_Q = AR + 187 * MiB, A_K = AR + 238 * MiB, A_VT = AR + 289 * MiB;
constexpr size_t A_ZR = AR + 102 * MiB, A_PZ = AR + 255 * MiB, A_ST = AR + 289 * MiB, A_DEC = AR + 357 * MiB;
constexpr size_t A_GATES = AR + 102 * MiB, A_MM = AR + 306 * MiB;
constexpr size_t A_PART = AR + 200 * MiB;
constexpr size_t WS_NEED = AR + 374 * MiB;

DI unsigned cvtpk(float lo, float hi) { f32x2_t v = {lo, hi}; bf16x2_t b = __builtin_convertvector(v, bf16x2_t); return __builtin_bit_cast(unsigned, b); }
DI float bflo(unsigned u) { return __uint_as_float(u << 16); }
DI float bfhi(unsigned u) { return __uint_as_float(u & 0xffff0000u); }
DI float bf2f(bf16_t u) { return __uint_as_float((unsigned)u << 16); }
DI bf16_t f2bf(float f) { return (bf16_t)(cvtpk(f, f) & 0xffffu); }
DI float shx(float v, int mask, int lane) { return __int_as_float(__builtin_amdgcn_ds_bpermute((lane ^ mask) << 2, __float_as_int(v))); }
DI float wave_sum(float v, int lane) {
#pragma unroll
    for (int o = 1; o < 64; o <<= 1) v += shx(v, o, lane);
    return v;
}
DI float sigm_f(float x) { return __builtin_amdgcn_rcpf(1.f + __builtin_amdgcn_exp2f(-1.4426950408889634f * x)); }
DI float silu_f(float x) { return x * sigm_f(x); }
DI int lane_asm() { int l_; asm volatile("v_mbcnt_lo_u32_b32 %0, -1, 0\n\tv_mbcnt_hi_u32_b32 %0, -1, %0" : "=v"(l_)); return l_; }
DI int crow(int r, int hi) { return (r & 3) + 8 * (r >> 2) + 4 * hi; }

namespace pg8 {
constexpr int BM = 256, BK = 64, HALF = 128, HTB = HALF * BK * 2, STAGE_BYTES = 8 * HTB, NXCD = 8, WGM = 4;
__host__ __device__ __forceinline__ int lds_byte(int r, int c) { const int st = (r >> 4) * 2 + (c >> 5), rr = r & 15, cc = c & 31, ob = rr * 64 + cc * 2; return st * 1024 + (ob ^ (((ob >> 9) & 1) << 5)); }
__host__ __device__ __forceinline__ void stage_rc(int b, int& R, int& C) { const int st = b / 1024, sb = b % 1024, swz = sb ^ (((sb >> 9) & 1) << 5); R = (st >> 1) * 16 + swz / 64; C = (st & 1) * 32 + (swz % 64) / 2; }
__host__ __device__ __forceinline__ int perm32(int rho) { const int n = rho >> 4, i = rho & 15; return 8 * (i >> 2) + 4 * n + (i & 3); }

struct Unit { int pm, pn, sel, kt0, nt, part; };
struct Gemm { const bf16_t* A0; const bf16_t* A1; const bf16_t* A2; const bf16_t* B0; const bf16_t* B1; const bf16_t* B2; int K; };

struct Sched {
    int nM, nN, nwg, G, c, split, rep, ntK, nfull, P, tot;
    DI void init(int M_, int N_, int K_, int G_, int c_, int split_ = 1 << 30, int rep_ = 1, int splitk = 0) {
        nM = M_ / BM; nN = N_ / BM; nwg = nM * nN; G = G_; c = c_; split = split_; rep = rep_; ntK = K_ / BK; nfull = nwg; P = 1; tot = ntK / 2;
        if (splitk && M_ == M && tot >= 8) { P = 8; nM = ML / BM; nfull = nM * nN; nwg = nfull; }
    }
    DI bool next(int i, Unit& u) const {
        const int ti = i / rep, sr = i - ti * rep;
        const long L = (long)ti * G + c; int tile, p = -1;
        if (L < nfull) tile = (int)L;
        else { if (P == 1) return false; const long q = L - nfull; if (q >= (long)(MC / BM) * nN * P) return false; tile = (int)(q / P); p = (int)(q % P);
            u.pm = ML / BM + tile / nN; u.pn = tile % nN; u.sel = 0; const int a0 = p * tot / P, a1 = (p + 1) * tot / P; u.kt0 = 2 * a0; u.nt = 2 * (a1 - a0); u.part = p + 1; return true; }
        int wgid = tile; { const int q = nwg / NXCD, r = nwg % NXCD, xcd = wgid % NXCD, off = wgid / NXCD; wgid = (xcd < r ? xcd * (q + 1) : r * (q + 1) + (xcd - r) * q) + off; }
        const int nig = WGM * nN, gid = wgid / nig, fm = gid * WGM, gsz = (nM - fm) < WGM ? (nM - fm) : WGM;
        u.pm = fm + ((wgid % nig) % gsz); u.pn = (wgid % nig) / gsz; u.sel = sr;
        if (rep == 1 && u.pn >= split) { u.sel = 1; u.pn -= split; }
        u.kt0 = 0; u.nt = ntK; u.part = 0; (void)p;
        return true;
    }
};

template <int ACT  > struct EpiStore {
    static constexpr bool PERM = true;
    bf16_t* O0; bf16_t* O1; int ldc0, ldc1; int split_cols; size_t split_stride;
    DI void operator()(const f32x4 (&acc)[2][2][4][2], const Unit& u, int wr, int wc, int fr, int fq) const {
        const int row0 = u.pm * BM + wr * 64 + fr; int colt = u.pn * BM; bf16_t* base = u.sel ? O1 : O0; const int ldc = u.sel ? ldc1 : ldc0;
        if (split_cols) { const int t = colt / split_cols; base += (size_t)t * split_stride; colt -= t * split_cols; }
        const int col0 = colt + wc * 32 + 8 * fq;
#pragma unroll
        for (int ai = 0; ai < 2; ++ai)
#pragma unroll
            for (int m = 0; m < 4; ++m) { bf16_t* rowp = base + (size_t)(row0 + ai * HALF + m * 16) * ldc + col0;
#pragma unroll
                for (int bj = 0; bj < 2; ++bj) { f32x4 v0 = acc[ai][bj][m][0], v1 = acc[ai][bj][m][1];
                    if (ACT == 2) {
#pragma unroll
                        for (int j = 0; j < 4; ++j) { v0[j] = sigm_f(v0[j]); v1[j] = sigm_f(v1[j]); } }
                    u32x4 w; w.x = cvtpk(v0[0], v0[1]); w.y = cvtpk(v0[2], v0[3]); w.z = cvtpk(v1[0], v1[1]); w.w = cvtpk(v1[2], v1[3]);
                    *(u32x4*)(rowp + bj * HALF) = w; } }
    }
};
struct EpiFfn13 {
    static constexpr bool PERM = true;
    bf16_t* G;
    DI void operator()(const f32x4 (&acc)[2][2][4][2], const Unit& u, int wr, int wc, int fr, int fq) const {
        const int row0 = u.pm * BM + wr * 64 + fr, col0 = u.pn * HALF + wc * 32 + 8 * fq;
#pragma unroll
        for (int ai = 0; ai < 2; ++ai)
#pragma unroll
            for (int m = 0; m < 4; ++m) { bf16_t* rowp = G + (size_t)(row0 + ai * HALF + m * 16) * DFF + col0;
                f32x4 v0, v1;
#pragma unroll
                for (int j = 0; j < 4; ++j) { v0[j] = silu_f(acc[ai][0][m][0][j]) * acc[ai][1][m][0][j]; v1[j] = silu_f(acc[ai][0][m][1][j]) * acc[ai][1][m][1][j]; }
                u32x4 w; w.x = cvtpk(v0[0], v0[1]); w.y = cvtpk(v0[2], v0[3]); w.z = cvtpk(v1[0], v1[1]); w.w = cvtpk(v1[2], v1[3]);
                *(u32x4*)rowp = w; }
    }
};
struct EpiResid {
    static constexpr bool PERM = false;
    float* out; unsigned char* wsb; const float* basel; int lyr; int modidx; float cs;
    DI void operator()(const f32x4 (&acc)[2][2][4][2], const Unit& u, int wr, int wc, int fr, int fq) const {
        const int br = u.pm < 128 ? (u.pm >> 4) : 8;
        float* hc = (float*)(wsb + WS_HC); float* part = (float*)(wsb + A_PART); const float* modl = (const float*)(wsb + WS_MOD) + (size_t)lyr * 9 * (NMOD * D);
        float* hb = u.pm < 128 ? out + (size_t)u.pm * BM * D : hc + (size_t)(u.pm - 128) * BM * D;
        const int col0 = u.pn * BM + wc * 32 + 4 * fq;
        const float* mp = modl + (size_t)br * (NMOD * D) + modidx * D + col0;
        f32x4 cf[2][2];
#pragma unroll
        for (int bj = 0; bj < 2; ++bj)
#pragma unroll
            for (int n = 0; n < 2; ++n) cf[bj][n] = *(const f32x4*)(mp + bj * HALF + n * 16) * cs;
        if (u.part) {
#pragma unroll
            for (int ai = 0; ai < 2; ++ai)
#pragma unroll
                for (int m = 0; m < 4; ++m) { float* rowp = hb + (size_t)(ai * HALF + wr * 64 + m * 16 + fr) * D + col0;
#pragma unroll
                    for (int bj = 0; bj < 2; ++bj)
#pragma unroll
                        for (int n = 0; n < 2; ++n) { float* p = rowp + bj * HALF + n * 16; *(f32x4*)(part + (size_t)(u.part - 1) * MC * D + (p - hc)) = cf[bj][n] * acc[ai][bj][m][n]; } }
        } else {
            const float* rb = (u.pm < 128) ? basel + (size_t)u.pm * BM * D : hb;
#pragma unroll
            for (int ai = 0; ai < 2; ++ai)
#pragma unroll
                for (int mp = 0; mp < 2; ++mp) { f32x4 hv[2][2][2];
#pragma unroll
                    for (int mm = 0; mm < 2; ++mm) { const float* rowp = rb + (size_t)(ai * HALF + wr * 64 + (2 * mp + mm) * 16 + fr) * D + col0;
#pragma unroll
                        for (int bj = 0; bj < 2; ++bj)
#pragma unroll
                            for (int n = 0; n < 2; ++n) hv[mm][bj][n] = *(const f32x4*)(rowp + bj * HALF + n * 16); }
                    __builtin_amdgcn_sched_barrier(0);
#pragma unroll
                    for (int mm = 0; mm < 2; ++mm) { float* rowp = hb + (size_t)(ai * HALF + wr * 64 + (2 * mp + mm) * 16 + fr) * D + col0;
#pragma unroll
                        for (int bj = 0; bj < 2; ++bj)
#pragma unroll
                            for (int n = 0; n < 2; ++n) *(f32x4*)(rowp + bj * HALF + n * 16) = hv[mm][bj][n] + cf[bj][n] * acc[ai][bj][2 * mp + mm][n]; }
                    __builtin_amdgcn_sched_barrier(0); }
        }
    }
};
struct EpiMerge {
    static constexpr bool PERM = true;
    const bf16_t* gates; bf16_t* mm_;
    DI void operator()(const f32x4 (&acc)[2][2][4][2], const Unit& u, int wr, int wc, int fr, int fq) const {
        const int row0 = u.pm * BM + wr * 64 + fr, col0 = u.pn * BM + wc * 32 + 8 * fq;
        const bf16_t* gb = gates + (size_t)u.sel * M * D;
        const bool accum = u.sel != 0;
#pragma unroll
        for (int ai = 0; ai < 2; ++ai)
#pragma unroll
            for (int mp = 0; mp < 2; ++mp) { u32x4 gvv[2][2], ovv[2][2];
#pragma unroll
                for (int mm = 0; mm < 2; ++mm) { const size_t off = (size_t)(row0 + ai * HALF + (2 * mp + mm) * 16) * D + col0;
#pragma unroll
                    for (int bj = 0; bj < 2; ++bj) { gvv[mm][bj] = *(const u32x4*)(gb + off + bj * HALF); ovv[mm][bj] = (u32x4){0u, 0u, 0u, 0u}; if (accum) ovv[mm][bj] = *(const u32x4*)(mm_ + off + bj * HALF); } }
                __builtin_amdgcn_sched_barrier(0);
#pragma unroll
                for (int mm = 0; mm < 2; ++mm) { const size_t off = (size_t)(row0 + ai * HALF + (2 * mp + mm) * 16) * D + col0;
#pragma unroll
                    for (int bj = 0; bj < 2; ++bj) { const u32x4 gv = gvv[mm][bj], o = ovv[mm][bj];
                        const f32x4 a0 = acc[ai][bj][2 * mp + mm][0], a1 = acc[ai][bj][2 * mp + mm][1];
                        float v[8] = {bflo(gv.x) * a0[0], bfhi(gv.x) * a0[1], bflo(gv.y) * a0[2], bfhi(gv.y) * a0[3], bflo(gv.z) * a1[0], bfhi(gv.z) * a1[1], bflo(gv.w) * a1[2], bfhi(gv.w) * a1[3]};
                        v[0] += bflo(o.x); v[1] += bfhi(o.x); v[2] += bflo(o.y); v[3] += bfhi(o.y); v[4] += bflo(o.z); v[5] += bfhi(o.z); v[6] += bflo(o.w); v[7] += bfhi(o.w);
                        u32x4 w; w.x = cvtpk(v[0], v[1]); w.y = cvtpk(v[2], v[3]); w.z = cvtpk(v[4], v[5]); w.w = cvtpk(v[6], v[7]);
                        *(u32x4*)(mm_ + off + bj * HALF) = w; } }
                __builtin_amdgcn_sched_barrier(0); }
    }
};

template <class Epi, bool ALIGN_EPI = true>
DI void gemm_phase(int tb_, LAS unsigned char* lds, const Gemm g, const Sched& S, const Epi& E) {
    int tid_ = tb_ + lane_asm(); asm volatile("" : "+v"(tid_));
    const int tid = tid_, wid = __builtin_amdgcn_readfirstlane(tid >> 6), lane = tid & 63, wr = wid >> 2, wc = wid & 3, fr = lane & 15, fq = lane >> 4;
    const int K = g.K;
    unsigned voffA[2], voffB[2];
#pragma unroll
    for (int i = 0; i < 2; ++i) { int R, C; stage_rc(tid * 16 + i * 8192, R, C); const int Rb = Epi::PERM ? ((R & ~31) + perm32(R & 31)) : R;
        voffA[i] = (unsigned)(R * K + C) * 2u; voffB[i] = (unsigned)(Rb * K + C) * 2u; }
    const size_t kstep = (size_t)(BK * 2);
    const size_t hstep = (size_t)HALF * K * 2;
    const size_t tstep = 2 * hstep;
    const unsigned ldsw = (unsigned)wid * 1024u;
    const int aoff = lds_byte(wr * 64 + fr, fq * 8), boff = lds_byte(wc * 32 + fr, fq * 8);
#define PG8_SA(b, h) (((b) * 2 + (h)) * HTB)
#define PG8_SB(b, h) ((4 + (b) * 2 + (h)) * HTB)
#define PG8_STAGE(bufoff, gbase, voff) do { _Pragma("unroll") for (int _i = 0; _i < 2; ++_i) \
        __builtin_amdgcn_global_load_lds((const unsigned*)((const char*)(gbase) + (voff)[_i]), (LAS unsigned*)(lds + (bufoff) + ldsw + _i * 8192), 16, 0, 0); } while (0)
#define PG8_LDA(dst, b, h) do { _Pragma("unroll") for (int m = 0; m < 4; ++m) _Pragma("unroll") for (int k = 0; k < 2; ++k) dst[m][k] = *(const LAS bf16x8*)(lds + PG8_SA(b, h) + aoff + m * 2048 + k * 1024); } while (0)
#define PG8_LDB(dst, b, h) do { _Pragma("unroll") for (int n = 0; n < 2; ++n) _Pragma("unroll") for (int k = 0; k < 2; ++k) dst[n][k] = *(const LAS bf16x8*)(lds + PG8_SB(b, h) + boff + n * 2048 + k * 1024); } while (0)
#define PG8_MMA(ai, bj, At, Bt) do { __builtin_amdgcn_s_setprio(1); _Pragma("unroll") for (int m = 0; m < 4; ++m) _Pragma("unroll") for (int n = 0; n < 2; ++n) _Pragma("unroll") for (int k = 0; k < 2; ++k) \
        acc[ai][bj][m][n] = __builtin_amdgcn_mfma_f32_16x16x32_bf16(Bt[n][k], At[m][k], acc[ai][bj][m][n], 0, 0, 0); __builtin_amdgcn_s_setprio(0); } while (0)
#define PG8_WAIT_V(n) asm volatile("s_waitcnt vmcnt(" #n ")" ::: "memory")
#define PG8_WAIT_L(n) asm volatile("s_waitcnt lgkmcnt(" #n ")" ::: "memory")
#define PG8_BAR __builtin_amdgcn_s_barrier()
#define PG8_SCHED __builtin_amdgcn_sched_barrier(0)
#define PG8_APTR(u) ((const char*)((u).sel == 0 ? g.A0 : ((u).sel == 1 ? g.A1 : g.A2)) + (size_t)(u).pm * tstep + (size_t)(u).kt0 * kstep)
#define PG8_BPTR(u) ((const char*)((u).sel == 0 ? g.B0 : ((u).sel == 1 ? g.B1 : g.B2)) + (size_t)(u).pn * tstep + (size_t)(u).kt0 * kstep)
    Unit cur, nxt; int ui = 0;
    if (!S.next(0, cur)) return;
    f32x4 acc[2][2][4][2];
#pragma unroll
    for (int a = 0; a < 2; ++a)
#pragma unroll
        for (int b = 0; b < 2; ++b)
#pragma unroll
            for (int m = 0; m < 4; ++m)
#pragma unroll
                for (int n = 0; n < 2; ++n) acc[a][b][m][n] = (f32x4){0.f, 0.f, 0.f, 0.f};
    bf16x8 At[4][2], B0[2][2], B1[2][2];
    const char* cA = PG8_APTR(cur); const char* cB = PG8_BPTR(cur);
    PG8_STAGE(PG8_SB(0, 0), cB, voffB); PG8_STAGE(PG8_SB(0, 1), cB + hstep, voffB); PG8_STAGE(PG8_SA(0, 0), cA, voffA); PG8_STAGE(PG8_SA(0, 1), cA + hstep, voffA);
    if (wr == 1) PG8_BAR;
    PG8_WAIT_V(2); PG8_BAR;
    PG8_STAGE(PG8_SB(1, 0), cB + kstep, voffB); PG8_STAGE(PG8_SA(1, 0), cA + kstep, voffA); PG8_STAGE(PG8_SB(1, 1), cB + hstep + kstep, voffB);
    PG8_WAIT_V(6); PG8_BAR;
    for (;;) {
        const bool has_next = S.next(ui + 1, nxt);
        const char* nA = has_next ? PG8_APTR(nxt) : cA; const char* nB = has_next ? PG8_BPTR(nxt) : cB;
        const int nt = cur.nt;
        for (int t = 0; t < nt; t += 2) {
            const bool last = (t == nt - 2);
            const char* a1 = cA + (size_t)(t + 1) * kstep;
            const char* a2 = last ? nA : cA + (size_t)(t + 2) * kstep; const char* b2 = last ? nB : cB + (size_t)(t + 2) * kstep;
            const char* a3 = a2 + kstep; const char* b3 = b2 + kstep;
            PG8_LDB(B0, 0, 0); PG8_LDB(B1, 0, 1); PG8_SCHED; PG8_LDA(At, 0, 0); PG8_STAGE(PG8_SA(1, 1), a1 + hstep, voffA);
            PG8_WAIT_V(8); PG8_WAIT_L(0); PG8_BAR; PG8_MMA(0, 0, At, B0); PG8_MMA(0, 1, At, B1); PG8_BAR; PG8_SCHED;
            PG8_LDA(At, 0, 1); PG8_STAGE(PG8_SB(0, 0), b2, voffB); PG8_STAGE(PG8_SB(0, 1), b2 + hstep, voffB); PG8_STAGE(PG8_SA(0, 0), a2, voffA);
            PG8_WAIT_V(8); PG8_WAIT_L(0); PG8_BAR; PG8_MMA(1, 0, At, B0); PG8_MMA(1, 1, At, B1); PG8_BAR; PG8_SCHED;
            PG8_LDB(B0, 1, 0); PG8_LDB(B1, 1, 1); PG8_SCHED; PG8_LDA(At, 1, 0); PG8_STAGE(PG8_SA(0, 1), a2 + hstep, voffA);
            PG8_WAIT_V(8); PG8_WAIT_L(0); PG8_BAR; PG8_MMA(0, 0, At, B0); PG8_MMA(0, 1, At, B1); PG8_BAR; PG8_SCHED;
            PG8_LDA(At, 1, 1); PG8_STAGE(PG8_SB(1, 0), b3, voffB); PG8_STAGE(PG8_SB(1, 1), b3 + hstep, voffB); PG8_STAGE(PG8_SA(1, 0), a3, voffA);
            PG8_WAIT_V(8); PG8_WAIT_L(0); PG8_BAR; PG8_MMA(1, 0, At, B0); PG8_MMA(1, 1, At, B1); PG8_BAR; PG8_SCHED;
        }
        if constexpr (ALIGN_EPI) { if (wr == 0) PG8_BAR; }
        E(acc, cur, wr, wc, fr, fq);
        if (!has_next) break;
#pragma unroll
        for (int a = 0; a < 2; ++a)
#pragma unroll
            for (int b = 0; b < 2; ++b)
#pragma unroll
                for (int m = 0; m < 4; ++m)
#pragma unroll
                    for (int n = 0; n < 2; ++n) acc[a][b][m][n] = (f32x4){0.f, 0.f, 0.f, 0.f};
        cur = nxt; cA = nA; cB = nB; ++ui;
        if constexpr (ALIGN_EPI) { if (wr == 1) PG8_BAR; }
    }
    PG8_WAIT_V(0);
    if constexpr (!ALIGN_EPI) { if (wr == 0) PG8_BAR; }
    PG8_BAR;
#undef PG8_SA
#undef PG8_SB
#undef PG8_STAGE
#undef PG8_LDA
#undef PG8_LDB
#undef PG8_MMA
#undef PG8_WAIT_V
#undef PG8_WAIT_L
#undef PG8_BAR
#undef PG8_SCHED
#undef PG8_APTR
#undef PG8_BPTR
}
}

#ifndef REPMASK
#define REPMASK 0
#endif
#define REPN(bit) (1 + ((REPMASK >> (bit)) & 1))
constexpr int NWAVES = 8, NTHR = 512;
constexpr int LDS_BYTES = 147456;
struct Args { const float* in[29]; float* out; unsigned char* ws; int ph_lo, ph_hi; };
typedef const __attribute__((address_space(4))) Args* ArgsP;
enum { I_X = 0, I_C, I_CTX, I_CCTX, I_WADA, I_BADA, I_GFFN1, I_F1W1, I_F1W3, I_F1W2, I_GMIX, I_WIN, I_GCQ, I_WUQ, I_GCKV, I_WUKV, I_GQN, I_GKN, I_WPOOL, I_PSCALE,
       I_WA2, I_BA2, I_GGLA, I_WBR, I_WOUT, I_GFFN2, I_F2W1, I_F2W3, I_F2W2 };

DI void tr_item(const float* W, int ld, int col0, bf16_t* WT, int pitch, int k_off, int row_off, int mode, const float* ks, const float* ns, int nblk, int item, float* scr, int lane) {
    const int kb = item / nblk, nb = item % nblk, k0 = 64 * kb, n0 = 32 * nb;
    { const int n4 = (lane & 7) * 4; f32x4 wv[8];
#pragma unroll
      for (int i = 0; i < 8; ++i) wv[i] = *(const f32x4*)(W + (size_t)(k0 + 8 * i + (lane >> 3)) * ld + col0 + n0 + n4);
#pragma unroll
      for (int i = 0; i < 8; ++i) { const int kk = 8 * i + (lane >> 3); f32x4 v = wv[i]; if (ks) v = v * ks[k0 + kk];
          float* d = scr + kk * 33 + n4; d[0] = v.x; d[1] = v.y; d[2] = v.z; d[3] = v.w; } }
    __builtin_amdgcn_s_waitcnt(0); asm volatile("" ::: "memory");
    const int c = lane & 7;
#pragma unroll
    for (int j = 0; j < 4; ++j) { const int n = (lane >> 3) + 8 * j; const float* s = scr + (8 * c) * 33 + n;
        const int nn = n0 + n; const int drow = mode ? (256 * (nn >> 7) + (nn & 127) + row_off) : (row_off + nn);
        const float sc = ns ? ns[drow] : 1.f;
        u32x4 o; o.x = cvtpk(s[0 * 33] * sc, s[1 * 33] * sc); o.y = cvtpk(s[2 * 33] * sc, s[3 * 33] * sc); o.z = cvtpk(s[4 * 33] * sc, s[5 * 33] * sc); o.w = cvtpk(s[6 * 33] * sc, s[7 * 33] * sc);
        *(u32x4*)(WT + (size_t)drow * pitch + k_off + k0 + 8 * c) = o; }
    __builtin_amdgcn_s_waitcnt(0); asm volatile("" ::: "memory");
}
#define TRJOB(W_, K_, ld_, col0_, ncols_, WT_, pitch_, koff_, rowoff_, mode_, ks_, ns_) do { const int nblk_ = (ncols_) / 32, nit_ = ((K_) / 64) * nblk_; \
    for (int it = gw; it < nit_; it += NGW) tr_item(W_, ld_, col0_, WT_, pitch_, koff_, rowoff_, mode_, ks_, ns_, nblk_, it, scr, lane); } while (0)

DI void phase_convert(ArgsP a, int tb_, int l, char* shm, int vcu, int G) {
    int tid_ = tb_ + lane_asm(); asm volatile("" : "+v"(tid_)); const int tid = tid_, lane = tid & 63, wave = tid >> 6;
    float* scr = (float*)(shm + wave * 8704);
    const int gw = vcu * NWAVES + wave, NGW = G * NWAVES;
    unsigned char* W = a->ws + WS_W;
    bf16_t* w13a = (bf16_t*)(W + W_13A); bf16_t* w2a = (bf16_t*)(W + W_2A); bf16_t* w13b = (bf16_t*)(W + W_13B); bf16_t* w2b = (bf16_t*)(W + W_2B);
    bf16_t* win = (bf16_t*)(W + W_IN); bf16_t* wuq = (bf16_t*)(W + W_UQ); bf16_t* wukv = (bf16_t*)(W + W_UKV); bf16_t* wpool = (bf16_t*)(W + W_POOL);
    bf16_t* wbr = (bf16_t*)(W + W_BR); bf16_t* wout = (bf16_t*)(W + W_OUT);
    const size_t fsz = (size_t)D * DFF;
    TRJOB(a->in[I_F1W1] + l * fsz, D, DFF, 0, DFF, w13a, D, 0, 0, 1, nullptr, nullptr);
    TRJOB(a->in[I_F1W3] + l * fsz, D, DFF, 0, DFF, w13a, D, 0, 128, 1, nullptr, nullptr);
    TRJOB(a->in[I_F1W2] + l * fsz, DFF, D, 0, D, w2a, DFF, 0, 0, 0, nullptr, nullptr);
    TRJOB(a->in[I_F2W1] + l * fsz, D, DFF, 0, DFF, w13b, D, 0, 0, 1, nullptr, nullptr);
    TRJOB(a->in[I_F2W3] + l * fsz, D, DFF, 0, DFF, w13b, D, 0, 128, 1, nullptr, nullptr);
    TRJOB(a->in[I_F2W2] + l * fsz, DFF, D, 0, D, w2b, DFF, 0, 0, 0, nullptr, nullptr);
    const float* wi = a->in[I_WIN] + (size_t)l * D * DIN;
    TRJOB(wi, D, DIN, 0, 416, win, D, 0, 0, 0, nullptr, nullptr);
    TRJOB(wi, D, DIN, 416, 1536, win, D, 0, 512, 0, nullptr, nullptr);
    TRJOB(wi, D, DIN, 1984, 512, win, D, 0, 2048, 0, nullptr, nullptr);
    TRJOB(wi, D, DIN, 1952, 32, win, D, 0, 2560, 0, nullptr, nullptr);
    TRJOB(wi, D, DIN, 2496, 3072, win, D, 0, 2816, 0, nullptr, nullptr);
    TRJOB(a->in[I_WUQ] + (size_t)l * 256 * 768, 256, 768, 0, 768, wuq, 256, 0, 0, 0, a->in[I_GCQ] + l * 256, nullptr);
    TRJOB(a->in[I_WUKV] + (size_t)l * 128 * 1024, 128, 1024, 0, 1024, wukv, 256, 0, 0, 0, a->in[I_GCKV] + l * 128, nullptr);
    for (int g = 0; g < 4; ++g) TRJOB(a->in[I_WPOOL] + (size_t)(l * 4 + g) * 128 * 128, 128, 128, 0, 128, wpool, 512, 128 * g, 128 * g, 0, nullptr, a->in[I_PSCALE] + l * 512);
    for (int i = 0; i < 3; ++i) TRJOB(a->in[I_WBR] + (size_t)(l * 3 + i) * 512 * 1024, 512, 1024, 0, 1024, wbr + (size_t)i * 1024 * 512, 512, 0, 0, 0, nullptr, nullptr);
    TRJOB(a->in[I_WOUT] + (size_t)l * D * D, D, D, 0, D, wout, D, 0, 0, 0, nullptr, nullptr);
    const int gt = vcu * NTHR + tid, NGT = G * NTHR; u32x4 z; asm volatile("v_mov_b32 %0, 0\n\tv_mov_b32 %1, 0\n\tv_mov_b32 %2, 0\n\tv_mov_b32 %3, 0" : "=v"(z.x), "=v"(z.y), "=v"(z.z), "=v"(z.w));
    if (l == 0) { float* rope = (float*)(a->ws + WS_ROPE);
        for (int i = gt; i < SEQ * 16; i += NGT) { const int t = i >> 4, af = i & 15, f = af & 7; const float inv = powf(10000.f, -(float)(2 * f) / 16.f);
            float sv, cv; sincosf((float)((af >> 3) ? (t & 63) : (t >> 6)) * inv, &sv, &cv); rope[t * 32 + af] = cv; rope[t * 32 + 16 + af] = sv; } }
    for (int i = gt; i < 96 * 128; i += NGT) *(u32x4*)(win + (size_t)(416 + i / 128) * D + (i % 128) * 8) = z;
    for (int i = gt; i < 224 * 128; i += NGT) *(u32x4*)(win + (size_t)(2592 + i / 128) * D + (i % 128) * 8) = z;
    for (int i = gt; i < 1024 * 16; i += NGT) *(u32x4*)(wukv + (size_t)(i / 16) * 256 + 128 + (i % 16) * 8) = z;
    for (int i = gt; i < 512 * 64; i += NGT) { const int r = i / 64, kc = i % 64; if ((kc >> 4) != (r >> 7)) *(u32x4*)(wpool + (size_t)r * 512 + kc * 8) = z; }
}

DI void phase_mod(ArgsP a, int tb_, char* shm, int vcu, int G) {
    int tid_ = tb_ + lane_asm(); asm volatile("" : "+v"(tid_)); const int tid = tid_, lane = tid & 63, wave = tid >> 6;
    float* sc = (float*)shm;
    float* part = (float*)(shm + 9 * 1024 * 4);
    for (int i = tid; i < 9 * D; i += NTHR) { const float v = i < 8 * D ? a->in[I_C][i] : a->in[I_CCTX][i - 8 * D]; sc[i] = silu_f(v); }
    __syncthreads();
    float* mod = (float*)(a->ws + WS_MOD);
    for (int it = vcu; it < 2 * 144; it += G) {
        const int l = it / 144, n0 = (it % 144) * 64;
        const float* w = a->in[I_WADA] + (size_t)l * D * (NMOD * D) + n0 + lane;
        float s[9];
#pragma unroll
        for (int r = 0; r < 9; ++r) s[r] = 0.f;
        const int kb = wave * 128;
#pragma unroll 4
        for (int k = 0; k < 128; ++k) { const float wv = w[(size_t)(kb + k) * (NMOD * D)];
#pragma unroll
            for (int r = 0; r < 9; ++r) s[r] += sc[r * D + kb + k] * wv; }
#pragma unroll
        for (int r = 0; r < 9; ++r) part[(wave * 9 + r) * 64 + lane] = s[r];
        __syncthreads();
        for (int i = tid; i < 9 * 64; i += NTHR) { const int r = i / 64, n = i % 64; float t = a->in[I_BADA][(size_t)l * (NMOD * D) + n0 + n];
#pragma unroll
            for (int w8 = 0; w8 < 8; ++w8) t += part[(w8 * 9 + r) * 64 + n];
            mod[((size_t)l * 9 + r) * (NMOD * D) + n0 + n] = t; }
        __syncthreads();
    }
}

DI void phase_normmod(ArgsP a, int tb_, int l, int which, bool first, bool addp, bool ctx0, int MR, int vcu, int G) {
    int tid_ = tb_ + lane_asm(); asm volatile("" : "+v"(tid_)); const int tid = tid_, lane = tid & 63, wave = tid >> 6;
    const int gw = vcu * NWAVES + wave, NGW = G * NWAVES;
    const float* g = (which == 0 ? a->in[I_GFFN1] : which == 1 ? a->in[I_GMIX] : a->in[I_GFFN2]) + l * D;
    const float* mod = (const float*)(a->ws + WS_MOD) + (size_t)l * 9 * (NMOD * D);
    float* hc = (float*)(a->ws + WS_HC); bf16_t* U = (bf16_t*)(a->ws + WS_U);
#define NM_SRC(mm) (first ? ((mm) < ML ? a->in[I_X] + (size_t)(mm) * D : a->in[I_CTX] + (size_t)((mm) - ML) * D) : ((mm) < ML ? a->out + (size_t)(mm) * D : (ctx0 ? a->in[I_CTX] + (size_t)((mm) - ML) * D : hc + (size_t)((mm) - ML) * D)))
    f32x4 nv[4];
    if (gw < MR) { const f32x4* xr = (const f32x4*)NM_SRC(gw) + lane;
#pragma unroll
        for (int j = 0; j < 4; ++j) nv[j] = xr[64 * j]; }
    for (int m = gw; m < MR; m += NGW) {
        const int br = m < ML ? (m >> 12) : 8;
        float* hrow = m < ML ? a->out + (size_t)m * D : hc + (size_t)(m - ML) * D;
        f32x4 v[4]; float s = 0.f;
#pragma unroll
        for (int j = 0; j < 4; ++j) v[j] = nv[j];
        { const int mn = m + NGW; if (mn < MR) { const f32x4* xr = (const f32x4*)NM_SRC(mn) + lane;
#pragma unroll
            for (int j = 0; j < 4; ++j) nv[j] = xr[64 * j]; } }
        const f32x4* gp = (const f32x4*)g + lane; const f32x4* sh = (const f32x4*)(mod + (size_t)br * (NMOD * D) + (3 * which) * D) + lane; const f32x4* scp = (const f32x4*)(mod + (size_t)br * (NMOD * D) + (3 * which + 1) * D) + lane;
        f32x4 gv[4], sv[4], cv[4];
#pragma unroll
        for (int j = 0; j < 4; ++j) { gv[j] = gp[64 * j]; sv[j] = sh[64 * j]; cv[j] = scp[64 * j] + 1.f; }
#pragma unroll
        for (int j = 0; j < 4; ++j) s += (v[j].x * v[j].x + v[j].y * v[j].y) + (v[j].z * v[j].z + v[j].w * v[j].w);
        if (addp && m >= ML) { const f32x4* pp = (const f32x4*)((const float*)(a->ws + A_PART) + (size_t)(m - ML) * D) + lane; s = 0.f;
#pragma unroll
            for (int jh = 0; jh < 2; ++jh) { f32x4 pv[2][8];
#pragma unroll
                for (int jj = 0; jj < 2; ++jj)
#pragma unroll
                    for (int p = 0; p < 8; ++p) pv[jj][p] = pp[(size_t)p * MC * (D / 4) + 64 * (2 * jh + jj)];
                __builtin_amdgcn_sched_barrier(0);
#pragma unroll
                for (int jj = 0; jj < 2; ++jj) { const int j = 2 * jh + jj;
#pragma unroll
                    for (int p = 0; p < 8; ++p) v[j] = v[j] + pv[jj][p];
                    s += (v[j].x * v[j].x + v[j].y * v[j].y) + (v[j].z * v[j].z + v[j].w * v[j].w); } } }
        if (addp && m >= ML) {
#pragma unroll
            for (int j = 0; j < 4; ++j) ((f32x4*)hrow + lane)[64 * j] = v[j]; }
        const float r = rsqrtf(wave_sum(s, lane) * (1.f / D) + EPS);
        u32x2* o = (u32x2*)(U + (size_t)m * D) + lane;
#pragma unroll
        for (int j = 0; j < 4; ++j) { const f32x4 y = v[j] * r * gv[j]; const f32x4 u = y * cv[j] + sv[j]; u32x2 w; w.x = cvtpk(u.x, u.y); w.y = cvtpk(u.z, u.w); o[64 * j] = w; }
    }
#undef NM_SRC
}

DI void phase_mla_fin(ArgsP a, int tb_, int l, char* shm, int vcu, int G) {
    int tid_ = tb_ + lane_asm(); asm volatile("" : "+v"(tid_)); const int tid = tid_, lane = tid & 63, wave = tid >> 6;
    const int gw = vcu * NWAVES + wave, NGW = G * NWAVES;
    const bf16_t* zcq = (const bf16_t*)(a->ws + A_ZCQ); const bf16_t* zkv = (const bf16_t*)(a->ws + A_ZKV);
    const bf16_t* qraw = (const bf16_t*)(a->ws + A_QRAW); const bf16_t* kvraw = (const bf16_t*)(a->ws + A_KVRAW);
    bf16_t* Qb = (bf16_t*)(a->ws + A_Q); bf16_t* Kb = (bf16_t*)(a->ws + A_K); bf16_t* Vt = (bf16_t*)(a->ws + A_VT);
    const float* gqn0 = a->in[I_GQN] + l * 96; const float* gkn0 = a->in[I_GKN] + l * 96;
#define UNPK(W_, E_) const float E_[8] = {bflo((W_).x), bfhi((W_).x), bflo((W_).y), bfhi((W_).y), bflo((W_).z), bfhi((W_).z), bflo((W_).w), bfhi((W_).w)}
#define SSQ8(W_, ACC_) do { UNPK(W_, e_); ACC_ += (e_[0] * e_[0] + e_[1] * e_[1]) + (e_[2] * e_[2] + e_[3] * e_[3]) + (e_[4] * e_[4] + e_[5] * e_[5]) + (e_[6] * e_[6] + e_[7] * e_[7]); } while (0)
#define ROPE32(xr) _Pragma("unroll") for (int ax = 0; ax < 2; ++ax) _Pragma("unroll") for (int f = 0; f < 8; ++f) { const float x1 = xr[16 * ax + f], x2 = xr[16 * ax + 8 + f], c = cs[8 * ax + f], sv = sn[8 * ax + f]; xr[16 * ax + f] = x1 * c - x2 * sv; xr[16 * ax + 8 + f] = x2 * c + x1 * sv; }
    for (int it = gw; it < (M / 8) * 2; it += NGW) {
        const int m = (it >> 1) * 8 + (lane >> 3), h = lane & 7;
        const bool lat = m < ML; const int t = lat ? (m & 4095) : ((m - ML) & 255); const int b = lat ? (m >> 12) : ((m - ML) >> 8); const int pos = lat ? LC + t : t;
        const size_t bh = (size_t)(b * 8 + h);
        const f32x4* rp = (const f32x4*)((const float*)(a->ws + WS_ROPE) + (size_t)(lat ? t : 0) * 32);
        f32x4 rc[4], rs[4];
#pragma unroll
        for (int i = 0; i < 4; ++i) { rc[i] = rp[i]; rs[i] = rp[4 + i]; }
        if (!(it & 1)) {
            const u32x4* ps = (const u32x4*)(zcq + (size_t)m * 256) + 4 * h; const u32x4* p = (const u32x4*)(qraw + (size_t)m * 768 + h * 96);
            u32x4 st[4], w[12];
#pragma unroll
            for (int i = 0; i < 4; ++i) st[i] = ps[i];
#pragma unroll
            for (int i = 0; i < 12; ++i) w[i] = p[i];
            const float* gqn = gqn0; asm volatile("" : "+s"(gqn));
            float cs[16], sn[16];
#pragma unroll
            for (int i = 0; i < 4; ++i) { cs[4 * i] = lat ? rc[i].x : 1.f; cs[4 * i + 1] = lat ? rc[i].y : 1.f; cs[4 * i + 2] = lat ? rc[i].z : 1.f; cs[4 * i + 3] = lat ? rc[i].w : 1.f;
                sn[4 * i] = lat ? rs[i].x : 0.f; sn[4 * i + 1] = lat ? rs[i].y : 0.f; sn[4 * i + 2] = lat ? rs[i].z : 0.f; sn[4 * i + 3] = lat ? rs[i].w : 0.f; }
            float ssq = 0.f, ss = 0.f;
#pragma unroll
            for (int i = 0; i < 4; ++i) SSQ8(st[i], ssq);
            ssq += shx(ssq, 1, lane); ssq += shx(ssq, 2, lane); ssq += shx(ssq, 4, lane);
            const float rq = rsqrtf(ssq * (1.f / 256.f) + EPS);
#pragma unroll
            for (int i = 0; i < 12; ++i) SSQ8(w[i], ss);
            const float rn = rsqrtf(ss * rq * rq * (1.f / 96.f) + EPS) * rq;
            u32x4* o = (u32x4*)(Qb + (bh * KVLEN + pos) * 96);
#pragma unroll
            for (int i = 0; i < 8; ++i) { UNPK(w[i], e); const float sc = rn * C2; u32x4 ow;
                ow.x = cvtpk(e[0] * sc * gqn[8 * i], e[1] * sc * gqn[8 * i + 1]); ow.y = cvtpk(e[2] * sc * gqn[8 * i + 2], e[3] * sc * gqn[8 * i + 3]);
                ow.z = cvtpk(e[4] * sc * gqn[8 * i + 4], e[5] * sc * gqn[8 * i + 5]); ow.w = cvtpk(e[6] * sc * gqn[8 * i + 6], e[7] * sc * gqn[8 * i + 7]); o[i] = ow; }
            float xr[32];
#pragma unroll
            for (int i = 0; i < 4; ++i) { UNPK(w[8 + i], e);
#pragma unroll
                for (int j = 0; j < 8; ++j) xr[8 * i + j] = e[j] * rn * C2 * gqn[64 + 8 * i + j]; }
            ROPE32(xr)
#pragma unroll
            for (int i = 0; i < 4; ++i) { u32x4 ow; ow.x = cvtpk(xr[8 * i], xr[8 * i + 1]); ow.y = cvtpk(xr[8 * i + 2], xr[8 * i + 3]); ow.z = cvtpk(xr[8 * i + 4], xr[8 * i + 5]); ow.w = cvtpk(xr[8 * i + 6], xr[8 * i + 7]); o[8 + i] = ow; }
        } else {
            const u32x4* pz = (const u32x4*)(zkv + (size_t)m * 256); const u32x4* p = (const u32x4*)(kvraw + (size_t)m * 1024 + h * 128);
            u32x4 st[2], krp[4], w[8], vw[8];
#pragma unroll
            for (int i = 0; i < 2; ++i) st[i] = pz[2 * h + i];
#pragma unroll
            for (int i = 0; i < 4; ++i) krp[i] = pz[16 + i];
#pragma unroll
            for (int i = 0; i < 8; ++i) { w[i] = p[i]; vw[i] = p[8 + i]; }
            const float* gkn = gkn0; asm volatile("" : "+s"(gkn));
            float sskv = 0.f, ss = 0.f, sk = 0.f;
#pragma unroll
            for (int i = 0; i < 2; ++i) SSQ8(st[i], sskv);
            sskv += shx(sskv, 1, lane); sskv += shx(sskv, 2, lane); sskv += shx(sskv, 4, lane);
            const float rkv = rsqrtf(sskv * (1.f / 128.f) + EPS);
            { bf16_t* vo = Vt + bh * 64 * KVLEN + pos;
#pragma unroll
              for (int i = 0; i < 8; ++i) { UNPK(vw[i], e);
#pragma unroll
                  for (int j = 0; j < 8; ++j) vo[(size_t)(8 * i + j) * KVLEN] = f2bf(e[j] * rkv); } }
#pragma unroll
            for (int i = 0; i < 8; ++i) SSQ8(w[i], ss);
#pragma unroll
            for (int i = 0; i < 4; ++i) SSQ8(krp[i], sk);
            const float rn = rsqrtf((ss * rkv * rkv + sk) * (1.f / 96.f) + EPS);
            u32x4* o = (u32x4*)(Kb + (bh * KVLEN + pos) * 96);
#pragma unroll
            for (int i = 0; i < 8; ++i) { UNPK(w[i], e); const float sc = rn * rkv; u32x4 ow;
                ow.x = cvtpk(e[0] * sc * gkn[8 * i], e[1] * sc * gkn[8 * i + 1]); ow.y = cvtpk(e[2] * sc * gkn[8 * i + 2], e[3] * sc * gkn[8 * i + 3]);
                ow.z = cvtpk(e[4] * sc * gkn[8 * i + 4], e[5] * sc * gkn[8 * i + 5]); ow.w = cvtpk(e[6] * sc * gkn[8 * i + 6], e[7] * sc * gkn[8 * i + 7]); o[i] = ow; }
            float cs[16], sn[16];
#pragma unroll
            for (int i = 0; i < 4; ++i) { cs[4 * i] = lat ? rc[i].x : 1.f; cs[4 * i + 1] = lat ? rc[i].y : 1.f; cs[4 * i + 2] = lat ? rc[i].z : 1.f; cs[4 * i + 3] = lat ? rc[i].w : 1.f;
                sn[4 * i] = lat ? rs[i].x : 0.f; sn[4 * i + 1] = lat ? rs[i].y : 0.f; sn[4 * i + 2] = lat ? rs[i].z : 0.f; sn[4 * i + 3] = lat ? rs[i].w : 0.f; }
            float xr[32];
#pragma unroll
            for (int i = 0; i < 4; ++i) { UNPK(krp[i], e);
#pragma unroll
                for (int j = 0; j < 8; ++j) xr[8 * i + j] = e[j] * rn * gkn[64 + 8 * i + j]; }
            ROPE32(xr)
#pragma unroll
            for (int i = 0; i < 4; ++i) { u32x4 ow; ow.x = cvtpk(xr[8 * i], xr[8 * i + 1]); ow.y = cvtpk(xr[8 * i + 2], xr[8 * i + 3]); ow.z = cvtpk(xr[8 * i + 4], xr[8 * i + 5]); ow.w = cvtpk(xr[8 * i + 6], xr[8 * i + 7]); o[8 + i] = ow; }
        }
    }
#undef UNPK
#undef SSQ8
#undef ROPE32
}

constexpr int AT_KP = 208, AT_VP = 136;
constexpr int AT_KB = 64 * AT_KP, AT_VB = 64 * AT_VP;
DI void attn_unit(int tb_, char* shm, const bf16_t* Qp, const bf16_t* Kp, const bf16_t* Vtp, int nkeys, int nrows, bf16_t* Op) {
    int tid_ = tb_ + lane_asm(); asm volatile("" : "+v"(tid_)); const int tid = tid_, lane = tid & 63, r32 = lane & 31, hi = lane >> 5, wid = __builtin_amdgcn_readfirstlane(tid >> 6);
    char* Kl = shm; char* Vl = shm + 2 * AT_KB; float* wsf = (float*)(shm + 2 * AT_KB + 2 * AT_VB) + wid * 32;
    const bool act = wid * 64 < nrows;
    bf16x8 qf0[6], qf1[6];
    { const bf16_t* qrow = Qp + (size_t)((act ? wid * 64 : 0) + r32) * 96 + hi * 8;
#pragma unroll
      for (int s = 0; s < 6; ++s) { qf0[s] = *(const bf16x8*)(qrow + 16 * s); qf1[s] = *(const bf16x8*)(qrow + 32 * 96 + 16 * s); } }
    const int kkey0 = tid / 12, kc0 = tid % 12, kkey1 = (tid + 512) / 12, kc1 = (tid + 512) % 12; const bool k1ok = tid < 256;
    const int vd = tid >> 3, vc = tid & 7;
    u32x4 kr0, kr1, vr; kr1 = (u32x4){0u, 0u, 0u, 0u};
#define AT_LOAD(t) do { kr0 = *(const u32x4*)(Kp + (size_t)((t) * 64 + kkey0) * 96 + kc0 * 8); if (k1ok) kr1 = *(const u32x4*)(Kp + (size_t)((t) * 64 + kkey1) * 96 + kc1 * 8); \
        vr = *(const u32x4*)(Vtp + (size_t)vd * KVLEN + (t) * 64 + vc * 8); } while (0)
#define AT_STORE(bf) do { *(u32x4*)(Kl + (bf) * AT_KB + kkey0 * AT_KP + kc0 * 16) = kr0; if (k1ok) *(u32x4*)(Kl + (bf) * AT_KB + kkey1 * AT_KP + kc1 * 16) = kr1; \
        *(u32x2*)(Vl + (bf) * AT_VB + vd * AT_VP + vc * 16) = (u32x2){vr.x, vr.y}; *(u32x2*)(Vl + (bf) * AT_VB + vd * AT_VP + vc * 16 + 8) = (u32x2){vr.z, vr.w}; } while (0)
#define MAX3(a_, b_, c_) ({ float r_; asm("v_max3_f32 %0, %1, %2, %3" : "=v"(r_) : "v"(a_), "v"(b_), "v"(c_)); r_; })
#define AT_SM(P0, P1, O0, O1, MR, LS, PA) do { \
        float mt = MAX3(P0[0], P0[1], P1[0]); mt = MAX3(mt, P1[1], P0[2]); \
        _Pragma("unroll") for (int r = 2; r < 16; r += 2) { mt = MAX3(mt, P0[r], P0[r + 1]); mt = MAX3(mt, P1[r], P1[r + 1]); } \
        mt = fmaxf(mt, shx(mt, 32, lane)); \
        if (__any(mt > MR + 8.f)) { \
            const float mnew = fmaxf(MR, mt); const float f = __builtin_amdgcn_exp2f(MR - mnew); LS *= f; MR = mnew; \
            if (hi == 0) wsf[r32] = f; \
            asm volatile("s_waitcnt lgkmcnt(0)" ::: "memory"); \
            _Pragma("unroll") for (int r = 0; r < 16; ++r) { const float fr = wsf[crow(r, hi)]; O0[r] *= fr; O1[r] *= fr; } \
        } \
        float ps = 0.f; \
        _Pragma("unroll") for (int r = 0; r < 16; ++r) { P0[r] = __builtin_amdgcn_exp2f(P0[r] - MR); P1[r] = __builtin_amdgcn_exp2f(P1[r] - MR); ps += P0[r]; ps += P1[r]; } \
        LS += ps; \
        _Pragma("unroll") for (int s2 = 0; s2 < 2; ++s2) { \
            u32x4 w; w.x = cvtpk(P0[8 * s2], P0[8 * s2 + 1]); w.y = cvtpk(P0[8 * s2 + 2], P0[8 * s2 + 3]); w.z = cvtpk(P0[8 * s2 + 4], P0[8 * s2 + 5]); w.w = cvtpk(P0[8 * s2 + 6], P0[8 * s2 + 7]); PA[s2] = __builtin_bit_cast(bf16x8, w); \
            u32x4 w2; w2.x = cvtpk(P1[8 * s2], P1[8 * s2 + 1]); w2.y = cvtpk(P1[8 * s2 + 2], P1[8 * s2 + 3]); w2.z = cvtpk(P1[8 * s2 + 4], P1[8 * s2 + 5]); w2.w = cvtpk(P1[8 * s2 + 6], P1[8 * s2 + 7]); PA[2 + s2] = __builtin_bit_cast(bf16x8, w2); } } while (0)
    const int nt = nkeys >> 6;
    f32x16 oa0, oa1, ob0, ob1;
#pragma unroll
    for (int r = 0; r < 16; ++r) { oa0[r] = 0.f; oa1[r] = 0.f; ob0[r] = 0.f; ob1[r] = 0.f; }
    float mra = -INFINITY, lsa = 0.f, mrb = -INFINITY, lsb = 0.f;
    AT_LOAD(0); AT_STORE(0); __syncthreads();
    for (int t = 0; t < nt; ++t) {
        const int bf = t & 1;
        if (t + 1 < nt) AT_LOAD(t + 1);
        if (act) {
            f32x16 pa0, pa1, pb0, pb1;
#pragma unroll
            for (int r = 0; r < 16; ++r) { pa0[r] = 0.f; pa1[r] = 0.f; pb0[r] = 0.f; pb1[r] = 0.f; }
            const char* kb = Kl + bf * AT_KB + r32 * AT_KP + 16 * hi;
#pragma unroll
            for (int s = 0; s < 6; ++s) { const bf16x8 k0 = *(const bf16x8*)(kb + 32 * s); const bf16x8 k1 = *(const bf16x8*)(kb + 32 * AT_KP + 32 * s);
                pa0 = __builtin_amdgcn_mfma_f32_32x32x16_bf16(k0, qf0[s], pa0, 0, 0, 0); pa1 = __builtin_amdgcn_mfma_f32_32x32x16_bf16(k1, qf0[s], pa1, 0, 0, 0);
                pb0 = __builtin_amdgcn_mfma_f32_32x32x16_bf16(k0, qf1[s], pb0, 0, 0, 0); pb1 = __builtin_amdgcn_mfma_f32_32x32x16_bf16(k1, qf1[s], pb1, 0, 0, 0); }
            bf16x8 qa[4], qb4[4];
            AT_SM(pa0, pa1, oa0, oa1, mra, lsa, qa);
            AT_SM(pb0, pb1, ob0, ob1, mrb, lsb, qb4);
            __builtin_amdgcn_sched_barrier(0);
            const char* vb = Vl + bf * AT_VB + r32 * AT_VP + 8 * hi;
#pragma unroll
            for (int kh = 0; kh < 2; ++kh) {
                u32x2 va0[2], va1[2], vc0[2], vc1[2];
#pragma unroll
                for (int k2 = 0; k2 < 2; ++k2) { const int ks = 2 * kh + k2; va0[k2] = *(const u32x2*)(vb + 32 * ks); va1[k2] = *(const u32x2*)(vb + 32 * ks + 16); vc0[k2] = *(const u32x2*)(vb + 32 * AT_VP + 32 * ks); vc1[k2] = *(const u32x2*)(vb + 32 * AT_VP + 32 * ks + 16); }
#pragma unroll
                for (int k2 = 0; k2 < 2; ++k2) { const int ks = 2 * kh + k2;
                    const bf16x8 vfa = __builtin_bit_cast(bf16x8, ((u32x4){va0[k2].x, va0[k2].y, va1[k2].x, va1[k2].y})), vfc = __builtin_bit_cast(bf16x8, ((u32x4){vc0[k2].x, vc0[k2].y, vc1[k2].x, vc1[k2].y}));
                    oa0 = __builtin_amdgcn_mfma_f32_32x32x16_bf16(qa[ks], vfa, oa0, 0, 0, 0); oa1 = __builtin_amdgcn_mfma_f32_32x32x16_bf16(qa[ks], vfc, oa1, 0, 0, 0);
                    ob0 = __builtin_amdgcn_mfma_f32_32x32x16_bf16(qb4[ks], vfa, ob0, 0, 0, 0); ob1 = __builtin_amdgcn_mfma_f32_32x32x16_bf16(qb4[ks], vfc, ob1, 0, 0, 0); }
                __builtin_amdgcn_sched_barrier(0);
            }
        }
        if (t + 1 < nt) AT_STORE(bf ^ 1);
        __syncthreads();
    }
    if (act) {
        lsa += shx(lsa, 32, lane); lsb += shx(lsb, 32, lane);
        if (hi == 0) wsf[r32] = lsa;
        asm volatile("s_waitcnt lgkmcnt(0)" ::: "memory");
#pragma unroll
        for (int r = 0; r < 16; ++r) { const float rl = 1.f / wsf[crow(r, hi)]; bf16_t* op = Op + (size_t)(wid * 64 + crow(r, hi)) * 512;
            op[r32] = f2bf(oa0[r] * rl); op[32 + r32] = f2bf(oa1[r] * rl); }
        asm volatile("s_waitcnt lgkmcnt(0)" ::: "memory");
        if (hi == 0) wsf[r32] = lsb;
        asm volatile("s_waitcnt lgkmcnt(0)" ::: "memory");
#pragma unroll
        for (int r = 0; r < 16; ++r) { const float rl = 1.f / wsf[crow(r, hi)]; bf16_t* op = Op + (size_t)(wid * 64 + 32 + crow(r, hi)) * 512;
            op[r32] = f2bf(ob0[r] * rl); op[32 + r32] = f2bf(ob1[r] * rl); }
    }
    __syncthreads();
#undef AT_LOAD
#undef AT_STORE
#undef AT_SM
#undef MAX3
}
DI void phase_attn(ArgsP a, int tb_, bool with_ctx, char* shm, int vcu, int G) {
    const bf16_t* Qb = (const bf16_t*)(a->ws + A_Q); const bf16_t* Kb = (const bf16_t*)(a->ws + A_K); const bf16_t* Vt = (const bf16_t*)(a->ws + A_VT);
    bf16_t* oa = (bf16_t*)(a->ws + A_OA);
    const int nu = 512 + (with_ctx ? 64 : 0);
    for (int u = vcu; u < nu; u += G) {
        const bool lat = u < 512; const int bh = lat ? (u >> 3) : (u - 512), qb = lat ? (u & 7) : 0, b = bh >> 3, h = bh & 7;
        const bf16_t* Qp = Qb + ((size_t)bh * KVLEN + (lat ? LC + qb * 512 : 0)) * 96;
        bf16_t* Op = oa + (lat ? ((size_t)b * SEQ + qb * 512) : ((size_t)ML + b * LC)) * 512 + h * 64;
        attn_unit(tb_, shm, Qp, Kb + (size_t)bh * KVLEN * 96, Vt + (size_t)bh * 64 * KVLEN, lat ? KVLEN : LC, lat ? 512 : 256, Op);
    }
}

DI void phase_poolprep(ArgsP a, int tb_, int MR, int vcu, int G) {
    const bf16_t* zr = (const bf16_t*)(a->ws + A_ZR); bf16_t* pz = (bf16_t*)(a->ws + A_PZ);
    int tid_ = tb_ + lane_asm(); asm volatile("" : "+v"(tid_)); const int gt = vcu * NTHR + tid_, NGT = G * NTHR;
    for (int i = gt; i < MR * 64; i += NGT) {
        const int m = i >> 6, c8 = i & 63, w2 = 1 << (c8 >> 4);
        const bool lat = m < ML; const int t = lat ? (m & 4095) : ((m - ML) & 255), Ls = lat ? SEQ : LC, mb = m - t;
        const int lo = max(t - w2, 0), hi = min(t + w2, Ls);
        float s[8];
#pragma unroll
        for (int j = 0; j < 8; ++j) s[j] = 0.f;
        const int cnt = hi - lo; const bf16_t* zp = zr + (size_t)(mb + lo) * ZR + c8 * 8;
        u32x4 wv[16];
#pragma unroll
        for (int r = 0; r < 16; ++r) { wv[r] = (u32x4){0u, 0u, 0u, 0u}; if (r < cnt) wv[r] = *(const u32x4*)(zp + (size_t)r * ZR); }
#pragma unroll
        for (int r = 0; r < 16; ++r) { const u32x4 w = wv[r];
            s[0] += bflo(w.x); s[1] += bfhi(w.x); s[2] += bflo(w.y); s[3] += bfhi(w.y); s[4] += bflo(w.z); s[5] += bfhi(w.z); s[6] += bflo(w.w); s[7] += bfhi(w.w); }
        const u32x4 w = *(const u32x4*)(zr + (size_t)m * ZR + c8 * 8); const float inv = 1.f / (float)(hi - lo);
        u32x4 o; o.x = cvtpk(s[0] * inv - bflo(w.x), s[1] * inv - bfhi(w.x)); o.y = cvtpk(s[2] * inv - bflo(w.y), s[3] * inv - bfhi(w.y));
        o.z = cvtpk(s[4] * inv - bflo(w.z), s[5] * inv - bfhi(w.z)); o.w = cvtpk(s[6] * inv - bflo(w.w), s[7] * inv - bfhi(w.w));
        *(u32x4*)(pz + (size_t)m * 512 + c8 * 8) = o;
    }
}

DI float logsig(float x) { return fminf(x, 0.f) - __logf(1.f + __expf(-fabsf(x))); }
DI int gla_row0(int b, int dir, int s) { if (s < 4) { const int c = dir ? 3 - s : s; return ML + b * LC + 64 * c; } const int c = dir ? 67 - s : s - 4; return b * SEQ + 64 * c; }
DI float scan64(float x, int lane) {
#pragma unroll
    for (int off = 1; off < 64; off <<= 1) { const float y = __int_as_float(__builtin_amdgcn_ds_bpermute((lane - off) << 2, __float_as_int(x))); if (lane >= off) x += y; }
    return x;
}
DI bf16x8 gla_wfrag(const float* w, int col, int hi) {
    u32x4 p; const float* q = w + (size_t)(8 * hi) * 256 + col;
    p.x = cvtpk(q[0], q[256]); p.y = cvtpk(q[512], q[768]); p.z = cvtpk(q[1024], q[1280]); p.w = cvtpk(q[1536], q[1792]);
    return __builtin_bit_cast(bf16x8, p);
}
DI void phase_gla1(ArgsP a, int tb_, int l, char* shm, int vcu, int G) {
    int tid_ = tb_ + lane_asm(); asm volatile("" : "+v"(tid_)); const int tid = tid_, lane = tid & 63, r32 = lane & 31, hi = lane >> 5, wid = tid >> 6;
    const bf16_t* zr = (const bf16_t*)(a->ws + A_ZR); bf16_t* ST = (bf16_t*)(a->ws + A_ST); float* DEC = (float*)(a->ws + A_DEC);
    float* LA = (float*)shm; char* KT = shm + 16640; char* VT = shm + 25856;
    for (int scan = vcu >> 2; scan < 64; scan += (G >> 2)) {
        const int dir = scan & 1, h = (scan >> 1) & 3, b = scan >> 3;
        const float* wa2 = a->in[I_WA2] + ((size_t)l * 2 + dir) * 16 * 256 + h * 64; const float* ba2 = a->in[I_BA2] + ((size_t)l * 2 + dir) * 256 + h * 64;
        const int jb = (wid >> 1) & 1, kb = wid & 1;
        const bf16x8 wfr = gla_wfrag(wa2, kb * 32 + r32, hi); const float bias = ba2[kb * 32 + r32];
        const int j = tid >> 3, kg = tid & 7, jl = dir ? 0 : 63;
#define GLA1_LOAD(S_, G_, K_, V0_, V1_) do { const int m0_ = gla_row0(b, dir, (S_)); G_ = *(const bf16x8*)(zr + (size_t)(m0_ + jb * 32 + r32) * ZR + 2048 + dir * 16 + 8 * hi); \
            K_ = *(const u32x4*)(zr + (size_t)(m0_ + j) * ZR + 768 + h * 64 + kg * 8); const u32x4* vp_ = (const u32x4*)(zr + (size_t)(m0_ + j) * ZR + 1024 + h * 128 + kg * 16); V0_ = vp_[0]; V1_ = vp_[1]; } while (0)
        bf16x8 ngfr; u32x4 nkw, nv0, nv1;
        GLA1_LOAD(vcu & 3, ngfr, nkw, nv0, nv1);
        for (int s = vcu & 3; s < NSLOT; s += 4) {
            const int item = scan * NSLOT + s;
            const bf16x8 gfr = ngfr; const u32x4 kw = nkw, v0 = nv0, v1 = nv1;
            if (s + 4 < NSLOT) GLA1_LOAD(s + 4, ngfr, nkw, nv0, nv1);
            if (wid < 4) { f32x16 acc;
#pragma unroll
                for (int r = 0; r < 16; ++r) acc[r] = 0.f;
                acc = __builtin_amdgcn_mfma_f32_32x32x16_bf16(gfr, wfr, acc, 0, 0, 0);
#pragma unroll
                for (int r = 0; r < 16; ++r) LA[(jb * 32 + crow(r, hi)) * 65 + kb * 32 + r32] = logsig(acc[r] + bias) * (1.f / 16.f); }
            __syncthreads();
#pragma unroll
            for (int i = 0; i < 8; ++i) { const int kd = wid * 8 + i, jj = dir ? 63 - lane : lane; const float x = scan64(LA[jj * 65 + kd], lane); LA[jj * 65 + kd] = x; }
            __syncthreads();
            { const float kv[8] = {bflo(kw.x), bfhi(kw.x), bflo(kw.y), bfhi(kw.y), bflo(kw.z), bfhi(kw.z), bflo(kw.w), bfhi(kw.w)};
#pragma unroll
              for (int kk = 0; kk < 8; ++kk) { const int kd = kg * 8 + kk; *(bf16_t*)(KT + kd * 144 + j * 2) = f2bf(kv[kk] * __expf(LA[jl * 65 + kd] - LA[j * 65 + kd])); }
              const unsigned vv[8] = {v0.x, v0.y, v0.z, v0.w, v1.x, v1.y, v1.z, v1.w};
#pragma unroll
              for (int q = 0; q < 8; ++q) { *(bf16_t*)(VT + (kg * 16 + 2 * q) * 144 + j * 2) = (bf16_t)(vv[q] & 0xffffu); *(bf16_t*)(VT + (kg * 16 + 2 * q + 1) * 144 + j * 2) = (bf16_t)(vv[q] >> 16); } }
            if (tid < 64) DEC[(size_t)item * 64 + tid] = __expf(LA[jl * 65 + tid]);
            __syncthreads();
            { const int kdb = wid >> 2, vb = wid & 3; f32x16 acc;
#pragma unroll
              for (int r = 0; r < 16; ++r) acc[r] = 0.f;
#pragma unroll
              for (int s4 = 0; s4 < 4; ++s4) { const bf16x8 af = *(const bf16x8*)(KT + (kdb * 32 + r32) * 144 + (16 * s4 + 8 * hi) * 2); const bf16x8 bfr = *(const bf16x8*)(VT + (vb * 32 + r32) * 144 + (16 * s4 + 8 * hi) * 2);
                  acc = __builtin_amdgcn_mfma_f32_32x32x16_bf16(af, bfr, acc, 0, 0, 0); }
              bf16_t* sp = ST + (size_t)item * 8192 + (size_t)(vb * 32 + r32) * 64 + kdb * 32 + 4 * hi;
#pragma unroll
              for (int g4 = 0; g4 < 4; ++g4) { u32x2 w; w.x = cvtpk(acc[4 * g4], acc[4 * g4 + 1]); w.y = cvtpk(acc[4 * g4 + 2], acc[4 * g4 + 3]); *(u32x2*)(sp + 8 * g4) = w; } }
        }
        __syncthreads();
    }
}
DI void phase_gla2(ArgsP a, int tb_, int vcu, int G) {
    bf16_t* ST = (bf16_t*)(a->ws + A_ST); const float* DEC = (const float*)(a->ws + A_DEC);
    int tid_ = tb_ + lane_asm(); asm volatile("" : "+v"(tid_)); const int gt = vcu * NTHR + tid_, NGT = G * NTHR;
    for (int e = gt; e < 64 * 128 * 16; e += NGT) {
        const int kd4 = e & 15, v = (e >> 4) & 127, scan = e >> 11;
        bf16_t* sp = ST + (size_t)scan * NSLOT * 8192 + v * 64 + kd4 * 4; const float* dp = DEC + (size_t)scan * NSLOT * 64 + kd4 * 4;
        float S0 = 0.f, S1 = 0.f, S2 = 0.f, S3 = 0.f;
        u32x2 dcur[4]; f32x4 ccur[4];
#pragma unroll
        for (int i = 0; i < 4; ++i) { dcur[i] = *(const u32x2*)(sp + (size_t)i * 8192); ccur[i] = *(const f32x4*)(dp + i * 64); }
        for (int g = 0; g < NSLOT / 4; ++g) {
            u32x2 dn[4]; f32x4 cn[4];
            if (g + 1 < NSLOT / 4) {
#pragma unroll
                for (int i = 0; i < 4; ++i) { dn[i] = *(const u32x2*)(sp + (size_t)(4 * g + 4 + i) * 8192); cn[i] = *(const f32x4*)(dp + (4 * g + 4 + i) * 64); } }
            else {
#pragma unroll
                for (int i = 0; i < 4; ++i) { dn[i] = dcur[i]; cn[i] = ccur[i]; } }
#pragma unroll
            for (int i = 0; i < 4; ++i) { u32x2 w; w.x = cvtpk(S0, S1); w.y = cvtpk(S2, S3); *(u32x2*)(sp + (size_t)(4 * g + i) * 8192) = w;
                S0 = ccur[i].x * S0 + bflo(dcur[i].x); S1 = ccur[i].y * S1 + bfhi(dcur[i].x); S2 = ccur[i].z * S2 + bflo(dcur[i].y); S3 = ccur[i].w * S3 + bfhi(dcur[i].y); }
#pragma unroll
            for (int i = 0; i < 4; ++i) { dcur[i] = dn[i]; ccur[i] = cn[i]; }
        }
    }
}
DI void phase_gla3(ArgsP a, int tb_, int l, bool with_ctx, char* shm, int vcu, int G) {
    int tid_ = tb_ + lane_asm(); asm volatile("" : "+v"(tid_)); const int tid = tid_, lane = tid & 63, r32 = lane & 31, hi = lane >> 5, wid = tid >> 6;
    const bf16_t* zr = (const bf16_t*)(a->ws + A_ZR); const bf16_t* ST = (const bf16_t*)(a->ws + A_ST); bf16_t* og = (bf16_t*)(a->ws + A_OG);
    float* LA = (float*)shm; char* QT = shm + 33792; char* KTt = shm + 52224; char* VT = shm + 70656; char* AM = shm + 89088; float* OS = (float*)shm;
    const float* ggl = a->in[I_GGLA] + l * 128;
    for (int bh = vcu >> 3; bh < 32; bh += (G >> 3)) {
        const int h = bh & 3, b = bh >> 2;
        const int ldir = wid >> 2, ljb = (wid >> 1) & 1, lkb = wid & 1;
        const float* wa2 = a->in[I_WA2] + ((size_t)l * 2 + ldir) * 16 * 256 + h * 64; const float* ba2 = a->in[I_BA2] + ((size_t)l * 2 + ldir) * 256 + h * 64;
        const bf16x8 wfr = gla_wfrag(wa2, lkb * 32 + r32, hi); const float bias = ba2[lkb * 32 + r32];
        const int j = tid >> 3, kg = tid & 7;
#define GLA3_M0(P_) ((P_) < 4 ? ML + b * LC + 64 * (P_) : b * SEQ + 64 * ((P_) - 4))
#define GLA3_LOAD(P_, G_, Q_, K_, V0_, V1_) do { const int m0_ = GLA3_M0(P_); G_ = *(const bf16x8*)(zr + (size_t)(m0_ + ljb * 32 + r32) * ZR + 2048 + ldir * 16 + 8 * hi); \
            Q_ = *(const u32x4*)(zr + (size_t)(m0_ + j) * ZR + 512 + h * 64 + kg * 8); K_ = *(const u32x4*)(zr + (size_t)(m0_ + j) * ZR + 768 + h * 64 + kg * 8); \
            const u32x4* vp_ = (const u32x4*)(zr + (size_t)(m0_ + j) * ZR + 1024 + h * 128 + kg * 16); V0_ = vp_[0]; V1_ = vp_[1]; } while (0)
        int pst = vcu & 7; if (pst < 4 && !with_ctx) pst += 8;
        bf16x8 ngfr; u32x4 nqw, nkw, nv0, nv1;
        GLA3_LOAD(pst, ngfr, nqw, nkw, nv0, nv1);
        for (int p = pst; p < NSLOT; p += 8) {
            const int m0 = GLA3_M0(p);
            const int slot_f = p, slot_b = p < 4 ? 3 - p : 71 - p;
            const bf16x8 gfr = ngfr; const u32x4 qw = nqw, kw = nkw, v0 = nv0, v1 = nv1;
            if (p + 8 < NSLOT) GLA3_LOAD(p + 8, ngfr, nqw, nkw, nv0, nv1);
            { f32x16 acc;
#pragma unroll
              for (int r = 0; r < 16; ++r) acc[r] = 0.f;
              acc = __builtin_amdgcn_mfma_f32_32x32x16_bf16(gfr, wfr, acc, 0, 0, 0);
#pragma unroll
              for (int r = 0; r < 16; ++r) LA[ldir * 4160 + (ljb * 32 + crow(r, hi)) * 65 + lkb * 32 + r32] = logsig(acc[r] + bias) * (1.f / 16.f); }
            __syncthreads();
            { const int dir = wid >> 2;
#pragma unroll
              for (int i = 0; i < 16; ++i) { const int kd = (wid & 3) * 16 + i, jj = dir ? 63 - lane : lane; const float x = scan64(LA[dir * 4160 + jj * 65 + kd], lane); LA[dir * 4160 + jj * 65 + kd] = x; } }
            __syncthreads();
            { const float qv[8] = {bflo(qw.x), bfhi(qw.x), bflo(qw.y), bfhi(qw.y), bflo(qw.z), bfhi(qw.z), bflo(qw.w), bfhi(qw.w)};
              const float kv[8] = {bflo(kw.x), bfhi(kw.x), bflo(kw.y), bfhi(kw.y), bflo(kw.z), bfhi(kw.z), bflo(kw.w), bfhi(kw.w)};
#pragma unroll
              for (int dir = 0; dir < 2; ++dir) { float qt[8], kt[8];
#pragma unroll
                  for (int kk = 0; kk < 8; ++kk) { const float e = LA[dir * 4160 + j * 65 + kg * 8 + kk]; qt[kk] = qv[kk] * 0.125f * __expf(e); kt[kk] = kv[kk] * __expf(-e); }
                  u32x4 w; w.x = cvtpk(qt[0], qt[1]); w.y = cvtpk(qt[2], qt[3]); w.z = cvtpk(qt[4], qt[5]); w.w = cvtpk(qt[6], qt[7]); *(u32x4*)(QT + dir * 9216 + j * 144 + kg * 16) = w;
                  u32x4 w2; w2.x = cvtpk(kt[0], kt[1]); w2.y = cvtpk(kt[2], kt[3]); w2.z = cvtpk(kt[4], kt[5]); w2.w = cvtpk(kt[6], kt[7]); *(u32x4*)(KTt + dir * 9216 + j * 144 + kg * 16) = w2; }
              const unsigned vv[8] = {v0.x, v0.y, v0.z, v0.w, v1.x, v1.y, v1.z, v1.w};
#pragma unroll
              for (int q = 0; q < 8; ++q) { *(bf16_t*)(VT + (kg * 16 + 2 * q) * 144 + j * 2) = (bf16_t)(vv[q] & 0xffffu); *(bf16_t*)(VT + (kg * 16 + 2 * q + 1) * 144 + j * 2) = (bf16_t)(vv[q] >> 16); } }
            const u32x4* rp = (const u32x4*)(zr + (size_t)(m0 + j) * ZR + 1536 + h * 128 + kg * 16); const u32x4 r0 = rp[0], r1 = rp[1];
            const int oib = wid >> 2, ovb = wid & 3;
            bf16x8 sfr[2][4];
#pragma unroll
            for (int dir = 0; dir < 2; ++dir) { const bf16_t* sp = ST + ((size_t)((b * 4 + h) * 2 + dir) * NSLOT + (dir ? slot_b : slot_f)) * 8192 + (size_t)(ovb * 32 + r32) * 64 + 8 * hi;
#pragma unroll
                for (int s4 = 0; s4 < 4; ++s4) sfr[dir][s4] = *(const bf16x8*)(sp + 16 * s4); }
            __syncthreads();
            { const int dir = wid >> 2, ib = (wid >> 1) & 1, jb = wid & 1; f32x16 acc;
#pragma unroll
              for (int r = 0; r < 16; ++r) acc[r] = 0.f;
#pragma unroll
              for (int s4 = 0; s4 < 4; ++s4) { const bf16x8 af = *(const bf16x8*)(QT + dir * 9216 + (ib * 32 + r32) * 144 + (16 * s4 + 8 * hi) * 2); const bf16x8 bfr = *(const bf16x8*)(KTt + dir * 9216 + (jb * 32 + r32) * 144 + (16 * s4 + 8 * hi) * 2);
                  acc = __builtin_amdgcn_mfma_f32_32x32x16_bf16(af, bfr, acc, 0, 0, 0); }
              const int jc = jb * 32 + r32;
#pragma unroll
              for (int r = 0; r < 16; ++r) { const int ir = ib * 32 + crow(r, hi); const bool keep = dir ? (jc >= ir) : (jc <= ir); *(bf16_t*)(AM + dir * 9216 + ir * 144 + jc * 2) = f2bf(keep ? acc[r] : 0.f); } }
            __syncthreads();
            { f32x16 acc;
#pragma unroll
              for (int r = 0; r < 16; ++r) acc[r] = 0.f;
#pragma unroll
              for (int dir = 0; dir < 2; ++dir) {
#pragma unroll
                  for (int s4 = 0; s4 < 4; ++s4) { const bf16x8 af = *(const bf16x8*)(AM + dir * 9216 + (oib * 32 + r32) * 144 + (16 * s4 + 8 * hi) * 2); const bf16x8 bfr = *(const bf16x8*)(VT + (ovb * 32 + r32) * 144 + (16 * s4 + 8 * hi) * 2);
                      acc = __builtin_amdgcn_mfma_f32_32x32x16_bf16(af, bfr, acc, 0, 0, 0); }
#pragma unroll
                  for (int s4 = 0; s4 < 4; ++s4) { const bf16x8 af = *(const bf16x8*)(QT + dir * 9216 + (oib * 32 + r32) * 144 + (16 * s4 + 8 * hi) * 2);
                      acc = __builtin_amdgcn_mfma_f32_32x32x16_bf16(af, sfr[dir][s4], acc, 0, 0, 0); } }
#pragma unroll
              for (int r = 0; r < 16; ++r) OS[(oib * 32 + crow(r, hi)) * 132 + ovb * 32 + r32] = acc[r]; }
            __syncthreads();
            { const int i = j, vg = kg; float o[16]; float ss = 0.f;
#pragma unroll
              for (int q = 0; q < 4; ++q) { const f32x4 t4 = *(const f32x4*)(OS + i * 132 + vg * 16 + 4 * q); o[4 * q] = t4.x; o[4 * q + 1] = t4.y; o[4 * q + 2] = t4.z; o[4 * q + 3] = t4.w; ss += (t4.x * t4.x + t4.y * t4.y) + (t4.z * t4.z + t4.w * t4.w); }
              ss += shx(ss, 1, lane); ss += shx(ss, 2, lane); ss += shx(ss, 4, lane);
              const float rn = rsqrtf(ss * (1.f / 128.f) + EPS);
              const float gr[16] = {bflo(r0.x), bfhi(r0.x), bflo(r0.y), bfhi(r0.y), bflo(r0.z), bfhi(r0.z), bflo(r0.w), bfhi(r0.w), bflo(r1.x), bfhi(r1.x), bflo(r1.y), bfhi(r1.y), bflo(r1.z), bfhi(r1.z), bflo(r1.w), bfhi(r1.w)};
              float y[16];
#pragma unroll
              for (int q = 0; q < 16; ++q) y[q] = o[q] * rn * ggl[vg * 16 + q] * silu_f(gr[q]);
              u32x4 w0, w1; w0.x = cvtpk(y[0], y[1]); w0.y = cvtpk(y[2], y[3]); w0.z = cvtpk(y[4], y[5]); w0.w = cvtpk(y[6], y[7]); w1.x = cvtpk(y[8], y[9]); w1.y = cvtpk(y[10], y[11]); w1.z = cvtpk(y[12], y[13]); w1.w = cvtpk(y[14], y[15]);
              u32x4* op = (u32x4*)(og + (size_t)(m0 + i) * 512 + h * 128 + vg * 16); op[0] = w0; op[1] = w1; }
            __syncthreads();
        }
    }
}

#define XB_TMO      128
#define XB_XCNT(j)  (256  + 64 * (j))
#define XB_XSUB(j)  (1280 + 64 * (j))
#define XB_XGEN(j)  (2304 + 64 * (j))
#define XB_TOP      3328
#define XB_TOPGEN   3392
#define XCD_BAR_WORDS 3456
#define XB_SPIN_CAP (1u << 18)
DI unsigned xb_ld(unsigned* p)              { return __hip_atomic_load(p, __ATOMIC_RELAXED, __HIP_MEMORY_SCOPE_AGENT); }
DI unsigned xb_add(unsigned* p, unsigned v) { return __hip_atomic_fetch_add(p, v, __ATOMIC_RELAXED, __HIP_MEMORY_SCOPE_AGENT); }
DI unsigned xb_xcc_id() { return (unsigned)__builtin_amdgcn_s_getreg((3 << 11) | 20) & 0xFu; }
#define XB_SPIN(cond, bar) do { unsigned _sp = 0; while (cond) { __builtin_amdgcn_s_sleep(1); \
    if ((++_sp & 255u) == 0u) { if (xb_ld(&(bar)[XB_TMO])) break; if (_sp > XB_SPIN_CAP) { atomicAdd(&(bar)[XB_TMO], 1u); break; } } } } while (0)
struct XcdBarrier { unsigned* bar; unsigned x; volatile LAS unsigned* st; };
DI XcdBarrier xcd_barrier_post(unsigned* bar, volatile LAS unsigned* st) {
    XcdBarrier b; b.bar = bar; b.x = xb_xcc_id(); b.st = st;
    if (threadIdx.x == 0) (void)xb_add(&bar[XB_XCNT(b.x)], 1u);
    return b;
}
DI void xcd_barrier_complete(unsigned* bar, unsigned x, unsigned& nloc, unsigned& nx) {
    const unsigned G = gridDim.x * gridDim.y * gridDim.z;
    unsigned sum, cnt, mine, sp = 0u;
    for (;;) {
        sum = 0u; cnt = 0u; mine = 0u;
#pragma unroll 1
        for (unsigned j = 0; j < 16; ++j) { const unsigned c = xb_ld(&bar[XB_XCNT(j)]); sum += c; cnt += (c > 0u) ? 1u : 0u; mine = (j == x) ? c : mine; }
        if (sum == G) break;
        __builtin_amdgcn_s_sleep(1);
        if ((++sp & 255u) == 0u) { if (xb_ld(&bar[XB_TMO])) break; if (sp > XB_SPIN_CAP) { atomicAdd(&bar[XB_TMO], 1u); break; } }
    }
    nloc = mine > 0u ? mine : 1u; nx = cnt > 0u ? cnt : 1u;
}
DI void xcd_barrier(const XcdBarrier& b, int tb_) {
    asm volatile("s_waitcnt vmcnt(0)" ::: "memory");
    __syncthreads();
    if (tb_ == 0 && lane_asm() == 0) {
        unsigned* bar = b.bar; unsigned bx_ = b.x; asm volatile("" : "+s"(bar), "+s"(bx_));
        __builtin_amdgcn_s_waitcnt(0);
        unsigned nloc = b.st[0], nx = b.st[1];
        if (nloc == 0u) { xcd_barrier_complete(bar, bx_, nloc, nx); b.st[0] = nloc; b.st[1] = nx; }
        const unsigned old = xb_add(&bar[XB_XSUB(bx_)], 1u);
        const unsigned gen = old / nloc;
        if (old + 1u == (gen + 1u) * nloc) {
            __builtin_amdgcn_fence(__ATOMIC_RELEASE, "agent");
            asm volatile("s_waitcnt vmcnt(0)" ::: "memory");
            const unsigned og = xb_add(&bar[XB_TOP], 1u);
            const unsigned tg = og / nx;
            if (og + 1u == (tg + 1u) * nx) xb_add(&bar[XB_TOPGEN], 1u);
            else XB_SPIN(xb_ld(&bar[XB_TOPGEN]) == tg, bar);
            __builtin_amdgcn_fence(__ATOMIC_ACQUIRE, "agent");
            xb_add(&bar[XB_XGEN(bx_)], 1u);
            asm volatile("s_waitcnt vmcnt(0)" ::: "memory");
        } else {
            XB_SPIN(xb_ld(&bar[XB_XGEN(bx_)]) == gen, bar);
            __builtin_amdgcn_fence(__ATOMIC_ACQUIRE, "agent");
            asm volatile("s_waitcnt vmcnt(0)" ::: "memory");
        }
    }
    __syncthreads();
}

__global__ void __launch_bounds__(NTHR, 2) mk_fwd(Args a_unused) {
    extern __shared__ __attribute__((aligned(16))) unsigned char lds[];
    cg::grid_group grid = cg::this_grid();
    char* shm = (char*)lds; LAS unsigned char* lds3 = (LAS unsigned char*)lds;
    const int tb_ = __builtin_amdgcn_readfirstlane((int)(threadIdx.x & ~63u));
    volatile LAS unsigned* bst = (volatile LAS unsigned*)(lds3 + 131072 + 64);
    if (threadIdx.x == 0) { bst[0] = 0u; bst[1] = 0u; }
    __syncthreads();
    const XcdBarrier bar = xcd_barrier_post((unsigned*)(a_unused.ws + WS_BAR), bst);
    if (a_unused.ph_hi < 0) grid.sync();
    int ph = 0;
#define PH_BEGIN { int G = gridDim.x, bx = blockIdx.x; asm volatile("" : "+s"(G), "+s"(bx)); const int vcu = (G % 8 == 0) ? (bx % 8) * (G / 8) + bx / 8 : bx; (void)vcu; ArgsP a = (ArgsP)__builtin_amdgcn_kernarg_segment_ptr(); asm volatile("" : "+s"(a)); unsigned char* ws = a->ws; bf16_t* U = (bf16_t*)(ws + WS_U); float* hc = (float*)(ws + WS_HC); unsigned char* W = ws + WS_W; \
    const float* modl = (const float*)(ws + WS_MOD) + (size_t)l * 9 * (NMOD * D); (void)U; (void)hc; (void)W; (void)modl;
#define PH_END(last) if (!(last)) { for (int r_ = 0; r_ < REPN(15); ++r_) { xcd_barrier(bar, tb_); } } } ++ph;

    for (int l = 0; l < 2; ++l) {
        const int MR = l == 0 ? M : ML;
        PH_BEGIN if (l == 0) phase_mod(a, tb_, shm, vcu, G); else phase_normmod(a, tb_, l, 0, false, true, false, M, vcu, G); __syncthreads(); phase_convert(a, tb_, l, shm, vcu, G); PH_END(false)
        if (l == 0) { PH_BEGIN phase_normmod(a, tb_, l, 0, true, false, false, M, vcu, G); PH_END(false) }
        PH_BEGIN { pg8::Gemm g{U, U, U, (const bf16_t*)(W + W_13A), (const bf16_t*)(W + W_13A), (const bf16_t*)(W + W_13A), D}; pg8::Sched S; S.init(M, 2 * DFF, D, G, bx);
            pg8::EpiFfn13 E{(bf16_t*)(ws + A_G)}; for (int r_ = 0; r_ < REPN(7); ++r_) pg8::gemm_phase<pg8::EpiFfn13>(tb_, lds3, g, S, E); } PH_END(false)
        PH_BEGIN { const bf16_t* A = (const bf16_t*)(ws + A_G); const bf16_t* B = (const bf16_t*)(W + W_2A); pg8::Gemm g{A, A, A, B, B, B, DFF}; pg8::Sched S; S.init(M, D, DFF, G, bx, 1 << 30, 1, 1);
            const float* bl = a->out; if (l == 0) bl = a->in[I_X]; pg8::EpiResid E{a->out, ws, bl, l, 2, 0.5f}; pg8::gemm_phase<pg8::EpiResid>(tb_, lds3, g, S, E); } PH_END(false)
        PH_BEGIN for (int r_ = 0; r_ < REPN(5); ++r_) phase_normmod(a, tb_, l, 1, false, true, l == 0, M, vcu, G); PH_END(false)
        PH_BEGIN { const bf16_t* B = (const bf16_t*)(W + W_IN); pg8::Gemm g{U, U, U, B, B + (size_t)256 * D, B, D}; pg8::Sched S; S.init(M, 512, D, G, bx, 1);
            pg8::EpiStore<0> E{(bf16_t*)(ws + A_ZCQ), (bf16_t*)(ws + A_ZKV), 256, 256, 0, 0}; pg8::gemm_phase<pg8::EpiStore<0>>(tb_, lds3, g, S, E); } PH_END(false)
        PH_BEGIN { const bf16_t* A0 = (const bf16_t*)(ws + A_ZCQ); const bf16_t* A1 = (const bf16_t*)(ws + A_ZKV); pg8::Gemm g{A0, A1, A0, (const bf16_t*)(W + W_UQ), (const bf16_t*)(W + W_UKV), (const bf16_t*)(W + W_UQ), 256};
            pg8::Sched S; S.init(M, 768 + 1024, 256, G, bx, 3);
            pg8::EpiStore<0> E{(bf16_t*)(ws + A_QRAW), (bf16_t*)(ws + A_KVRAW), 768, 1024, 0, 0}; pg8::gemm_phase<pg8::EpiStore<0>>(tb_, lds3, g, S, E); } PH_END(false)
        PH_BEGIN for (int r_ = 0; r_ < REPN(1); ++r_) phase_mla_fin(a, tb_, l, shm, vcu, G); PH_END(false)
        PH_BEGIN for (int r_ = 0; r_ < REPN(0); ++r_) phase_attn(a, tb_, l == 0, shm, vcu, G); PH_END(false)
        PH_BEGIN { const bf16_t* B = (const bf16_t*)(W + W_IN) + (size_t)512 * D; pg8::Gemm g{U, U, U, B, B, B, D}; pg8::Sched S; S.init(M, ZR, D, G, bx);
            pg8::EpiStore<0> E{(bf16_t*)(ws + A_ZR), (bf16_t*)(ws + A_ZR), ZR, ZR, 0, 0}; pg8::gemm_phase<pg8::EpiStore<0>>(tb_, lds3, g, S, E); } PH_END(false)
        PH_BEGIN for (int r_ = 0; r_ < REPN(2); ++r_) phase_poolprep(a, tb_, MR, vcu, G); for (int r_ = 0; r_ < REPN(3); ++r_) phase_gla1(a, tb_, l, shm, vcu, G); PH_END(false)
        PH_BEGIN phase_gla2(a, tb_, vcu, G); __syncthreads();
            { const bf16_t* A = (const bf16_t*)(ws + A_PZ); const bf16_t* B = (const bf16_t*)(W + W_POOL); pg8::Gemm g{A, A, A, B, B, B, 512}; pg8::Sched S; S.init(MR, 512, 512, G, bx);
              pg8::EpiStore<0> E{(bf16_t*)(ws + A_OP), (bf16_t*)(ws + A_OP), 512, 512, 0, 0}; pg8::gemm_phase<pg8::EpiStore<0>>(tb_, lds3, g, S, E); } PH_END(false)
        PH_BEGIN for (int r_ = 0; r_ < REPN(4); ++r_) phase_gla3(a, tb_, l, l == 0, shm, vcu, G); PH_END(false)
        PH_BEGIN { const bf16_t* B = (const bf16_t*)(W + W_IN) + (size_t)2816 * D; pg8::Gemm g{U, U, U, B, B, B, D}; pg8::Sched S; S.init(MR, 3072, D, G, bx);
            pg8::EpiStore<2> E{(bf16_t*)(ws + A_GATES), (bf16_t*)(ws + A_GATES), D, D, 1024, (size_t)M * D}; for (int r_ = 0; r_ < REPN(10); ++r_) pg8::gemm_phase<pg8::EpiStore<2>>(tb_, lds3, g, S, E); } PH_END(false)
        PH_BEGIN { const bf16_t* B = (const bf16_t*)(W + W_BR); pg8::Gemm g{(const bf16_t*)(ws + A_OA), (const bf16_t*)(ws + A_OP), (const bf16_t*)(ws + A_OG), B, B + (size_t)1024 * 512, B + (size_t)2 * 1024 * 512, 512};
            pg8::Sched S; S.init(MR, D, 512, G, bx, 1 << 30, 3);
            pg8::EpiMerge E{(const bf16_t*)(ws + A_GATES), (bf16_t*)(ws + A_MM)}; for (int r_ = 0; r_ < REPN(11); ++r_) pg8::gemm_phase<pg8::EpiMerge>(tb_, lds3, g, S, E); } PH_END(false)
        PH_BEGIN { const bf16_t* A = (const bf16_t*)(ws + A_MM); const bf16_t* B = (const bf16_t*)(W + W_OUT); pg8::Gemm g{A, A, A, B, B, B, D}; pg8::Sched S; S.init(MR, D, D, G, bx, 1 << 30, 1, 1);
            pg8::EpiResid E{a->out, ws, a->out, l, 5, 1.0f}; pg8::gemm_phase<pg8::EpiResid>(tb_, lds3, g, S, E); } PH_END(false)
        PH_BEGIN phase_normmod(a, tb_, l, 2, false, l == 0, false, MR, vcu, G); PH_END(false)
        PH_BEGIN { pg8::Gemm g{U, U, U, (const bf16_t*)(W + W_13B), (const bf16_t*)(W + W_13B), (const bf16_t*)(W + W_13B), D}; pg8::Sched S; S.init(MR, 2 * DFF, D, G, bx);
            pg8::EpiFfn13 E{(bf16_t*)(ws + A_G)}; for (int r_ = 0; r_ < REPN(7); ++r_) pg8::gemm_phase<pg8::EpiFfn13>(tb_, lds3, g, S, E); } PH_END(false)
        PH_BEGIN { const bf16_t* A = (const bf16_t*)(ws + A_G); const bf16_t* B = (const bf16_t*)(W + W_2B); pg8::Gemm g{A, A, A, B, B, B, DFF}; pg8::Sched S; S.init(MR, D, DFF, G, bx, 1 << 30, 1, 1);
            pg8::EpiResid E{a->out, ws, a->out, l, 8, 0.5f}; pg8::gemm_phase<pg8::EpiResid>(tb_, lds3, g, S, E); } PH_END(l == 1)
    }
}

extern "C" void kernel_launch(void* const* d_in, const int* in_sizes, int n_in, void* d_out, int out_size, void* d_ws, size_t ws_size, hipStream_t stream) {
    static int grid = 0;
    if (grid == 0) {
        if (n_in != 29 || out_size != ML * D || ws_size < WS_NEED) { fprintf(stderr, "kernel_launch: unexpected shapes: n_in %d out %d ws %zu (need %zu)\n", n_in, out_size, ws_size, (size_t)WS_NEED); grid = -1; return; }
        int dev = 0, cus = 0, per_cu = 0;
        hipGetDevice(&dev); hipDeviceGetAttribute(&cus, hipDeviceAttributeMultiprocessorCount, dev);
        if (hipFuncSetAttribute((const void*)mk_fwd, hipFuncAttributeMaxDynamicSharedMemorySize, LDS_BYTES) != hipSuccess) { fprintf(stderr, "kernel_launch: hipFuncSetAttribute failed\n"); grid = -1; return; }
        if (hipOccupancyMaxActiveBlocksPerMultiprocessor(&per_cu, (const void*)mk_fwd, NTHR, LDS_BYTES) != hipSuccess || per_cu < 1) { fprintf(stderr, "kernel_launch: occupancy query says %d\n", per_cu); per_cu = 1; }
        (void)hipGetLastError();
        grid = cus;
    }
    if (grid < 0) return;
    if (hipMemsetAsync((char*)d_ws + WS_BAR, 0, 16384, stream) != hipSuccess) { fprintf(stderr, "kernel_launch: memset failed\n"); return; }
    Args a{};
    for (int i = 0; i < 29; ++i) a.in[i] = (const float*)d_in[i];
    a.out = (float*)d_out; a.ws = (unsigned char*)d_ws; a.ph_lo = 0; a.ph_hi = 1000;
    void* args[] = {&a};
    hipError_t e = hipLaunchCooperativeKernel((const void*)mk_fwd, dim3(grid), dim3(NTHR), args, LDS_BYTES, stream);
    if (e != hipSuccess) fprintf(stderr, "cooperative launch failed: %s (grid %d)\n", hipGetErrorString(e), grid);
}
```

```cpp
#include <hip/hip_runtime.h>
#include <hip/hip_cooperative_groups.h>
#include <cstdio>
#include <cstdint>
namespace cg = cooperative_groups;

#define DI __device__ __forceinline__
#define LAS __attribute__((address_space(3)))
typedef unsigned short bf16_t;
typedef short bf16x8 __attribute__((ext_vector_type(8)));
typedef short s16x4 __attribute__((ext_vector_type(4)));
typedef float f32x4 __attribute__((ext_vector_type(4)));
typedef float f32x16 __attribute__((ext_vector_type(16)));
typedef unsigned u32x4 __attribute__((ext_vector_type(4)));
typedef unsigned u32x2 __attribute__((ext_vector_type(2)));
typedef float f32x2_t __attribute__((ext_vector_type(2)));
typedef __bf16 bf16x2_t __attribute__((ext_vector_type(2)));

constexpr int D = 1024, NB = 8, SEQ = 4096, LC = 256, ML = NB * SEQ, MC = NB * LC, M = ML + MC;
constexpr int DFF = 2816, DIN = 5568, NMOD = 9;
constexpr int KVLEN = LC + SEQ;
constexpr int ZR = 2304;
constexpr int NSLOT = 68;
constexpr float EPS = 1e-6f;
constexpr float C2 = 0.10206207261596577f * 1.4426950408889634f;

constexpr size_t MiB = 1u << 20;
constexpr size_t WS_ROPE = 0;
constexpr size_t WS_BAR = 768 * 1024;
constexpr size_t WS_MOD = 1 * MiB;
constexpr size_t WS_HC = 2 * MiB;
constexpr size_t WS_U = 10 * MiB;
constexpr size_t WS_W = 78 * MiB;
constexpr size_t W_13A = 0, W_2A = 11 * MiB, W_13B = W_2A + 5767168, W_2B = W_13B + 11 * MiB, W_IN = W_2B + 5767168;
constexpr size_t W_UQ = W_IN + (size_t)5888 * 1024 * 2, W_UKV = W_UQ + 768 * 256 * 2, W_POOL = W_UKV + 1024 * 256 * 2;
constexpr size_t W_BR = W_POOL + 512 * 512 * 2, W_OUT = W_BR + (size_t)3 * 1024 * 512 * 2, W_END = W_OUT + 1024 * 1024 * 2;
static_assert(W_END <= 52 * MiB, "weights");
constexpr size_t AR = 130 * MiB;
constexpr size_t A_G = AR;
constexpr size_t A_OA = AR, A_OP = AR + 34 * MiB, A_OG = AR + 68 * MiB;
constexpr size_t A_ZCQ = AR + 34 * MiB, A_ZKV = AR + 51 * MiB, A_QRAW = AR + 68 * MiB, A_KVRAW = AR + 119 * MiB;
constexpr size_t A_Q = AR + 187 * MiB, A_K = AR + 238 * MiB, A_VT = AR + 289 * MiB;
constexpr size_t A_ZR = AR + 102 * MiB, A_PZ = AR + 255 * MiB, A_ST = AR + 289 * MiB, A_DEC = AR + 357 * MiB;
constexpr size_t A_GATES = AR + 102 * MiB, A_MM = AR + 306 * MiB;
constexpr size_t A_PART = AR + 200 * MiB;
constexpr size_t WS_NEED = AR + 374 * MiB;

DI unsigned cvtpk(float lo, float hi) { f32x2_t v = {lo, hi}; bf16x2_t b = __builtin_convertvector(v, bf16x2_t); return __builtin_bit_cast(unsigned, b); }
DI float bflo(unsigned u) { return __uint_as_float(u << 16); }
DI float bfhi(unsigned u) { return __uint_as_float(u & 0xffff0000u); }
DI float bf2f(bf16_t u) { return __uint_as_float((unsigned)u << 16); }
DI bf16_t f2bf(float f) { return (bf16_t)(cvtpk(f, f) & 0xffffu); }
DI float shx(float v, int mask, int lane) { return __int_as_float(__builtin_amdgcn_ds_bpermute((lane ^ mask) << 2, __float_as_int(v))); }
DI float wave_sum(float v, int lane) {
#pragma unroll
    for (int o = 1; o < 64; o <<= 1) v += shx(v, o, lane);
    return v;
}
DI float sigm_f(float x) { return __builtin_amdgcn_rcpf(1.f + __builtin_amdgcn_exp2f(-1.4426950408889634f * x)); }
DI float silu_f(float x) { return x * sigm_f(x); }
DI int lane_asm() { int l_; asm volatile("v_mbcnt_lo_u32_b32 %0, -1, 0\n\tv_mbcnt_hi_u32_b32 %0, -1, %0" : "=v"(l_)); return l_; }
DI int crow(int r, int hi) { return (r & 3) + 8 * (r >> 2) + 4 * hi; }

namespace pg8 {
constexpr int BM = 256, BK = 64, HALF = 128, HTB = HALF * BK * 2, STAGE_BYTES = 8 * HTB, NXCD = 8, WGM = 4;
__host__ __device__ __forceinline__ int lds_byte(int r, int c) { const int st = (r >> 4) * 2 + (c >> 5), rr = r & 15, cc = c & 31, ob = rr * 64 + cc * 2; return st * 1024 + (ob ^ (((ob >> 9) & 1) << 5)); }
__host__ __device__ __forceinline__ void stage_rc(int b, int& R, int& C) { const int st = b / 1024, sb = b % 1024, swz = sb ^ (((sb >> 9) & 1) << 5); R = (st >> 1) * 16 + swz / 64; C = (st & 1) * 32 + (swz % 64) / 2; }
__host__ __device__ __forceinline__ int perm32(int rho) { const int n = rho >> 4, i = rho & 15; return 8 * (i >> 2) + 4 * n + (i & 3); }

struct Unit { int pm, pn, sel, kt0, nt, part; };
struct Gemm { const bf16_t* A0; const bf16_t* A1; const bf16_t* A2; const bf16_t* B0; const bf16_t* B1; const bf16_t* B2; int K; };

struct Sched {
    int nM, nN, nwg, G, c, split, rep, ntK, nfull, P, tot;
    DI void init(int M_, int N_, int K_, int G_, int c_, int split_ = 1 << 30, int rep_ = 1, int splitk = 0) {
        nM = M_ / BM; nN = N_ / BM; nwg = nM * nN; G = G_; c = c_; split = split_; rep = rep_; ntK = K_ / BK; nfull = nwg; P = 1; tot = ntK / 2;
        if (splitk && M_ == M && tot >= 8) { P = 8; nM = ML / BM; nfull = nM * nN; nwg = nfull; }
    }
    DI bool next(int i, Unit& u) const {
        const int ti = i / rep, sr = i - ti * rep;
        const long L = (long)ti * G + c; int tile, p = -1;
        if (L < nfull) tile = (int)L;
        else { if (P == 1) return false; const long q = L - nfull; if (q >= (long)(MC / BM) * nN * P) return false; tile = (int)(q / P); p = (int)(q % P);
            u.pm = ML / BM + tile / nN; u.pn = tile % nN; u.sel = 0; const int a0 = p * tot / P, a1 = (p + 1) * tot / P; u.kt0 = 2 * a0; u.nt = 2 * (a1 - a0); u.part = p + 1; return true; }
        int wgid = tile; { const int q = nwg / NXCD, r = nwg % NXCD, xcd = wgid % NXCD, off = wgid / NXCD; wgid = (xcd < r ? xcd * (q + 1) : r * (q + 1) + (xcd - r) * q) + off; }
        const int nig = WGM * nN, gid = wgid / nig, fm = gid * WGM, gsz = (nM - fm) < WGM ? (nM - fm) : WGM;
        u.pm = fm + ((wgid % nig) % gsz); u.pn = (wgid % nig) / gsz; u.sel = sr;
        if (rep == 1 && u.pn >= split) { u.sel = 1; u.pn -= split; }
        u.kt0 = 0; u.nt = ntK; u.part = 0; (void)p;
        return true;
    }
};

template <int ACT  > struct EpiStore {
    static constexpr bool PERM = true, CHAIN = false;
    bf16_t* O0; bf16_t* O1; int ldc0, ldc1; int split_cols; size_t split_stride;
    DI void operator()(const f32x4 (&acc)[2][2][4][2], const Unit& u, int wr, int wc, int fr, int fq) const {
        const int row0 = u.pm * BM + wr * 64 + fr; int colt = u.pn * BM; bf16_t* base = u.sel ? O1 : O0; const int ldc = u.sel ? ldc1 : ldc0;
        if (split_cols) { const int t = colt / split_cols; base += (size_t)t * split_stride; colt -= t * split_cols; }
        const int col0 = colt + wc * 32 + 8 * fq;
#pragma unroll
        for (int ai = 0; ai < 2; ++ai)
#pragma unroll
            for (int m = 0; m < 4; ++m) { bf16_t* rowp = base + (size_t)(row0 + ai * HALF + m * 16) * ldc + col0;
#pragma unroll
                for (int bj = 0; bj < 2; ++bj) { f32x4 v0 = acc[ai][bj][m][0], v1 = acc[ai][bj][m][1];
                    if (ACT == 2) {
#pragma unroll
                        for (int j = 0; j < 4; ++j) { v0[j] = sigm_f(v0[j]); v1[j] = sigm_f(v1[j]); } }
                    u32x4 w; w.x = cvtpk(v0[0], v0[1]); w.y = cvtpk(v0[2], v0[3]); w.z = cvtpk(v1[0], v1[1]); w.w = cvtpk(v1[2], v1[3]);
                    *(u32x4*)(rowp + bj * HALF) = w; } }
    }
};
struct EpiFfn13 {
    static constexpr bool PERM = true, CHAIN = false;
    bf16_t* G;
    DI void operator()(const f32x4 (&acc)[2][2][4][2], const Unit& u, int wr, int wc, int fr, int fq) const {
        const int row0 = u.pm * BM + wr * 64 + fr, col0 = u.pn * HALF + wc * 32 + 8 * fq;
#pragma unroll
        for (int ai = 0; ai < 2; ++ai)
#pragma unroll
            for (int m = 0; m < 4; ++m) { bf16_t* rowp = G + (size_t)(row0 + ai * HALF + m * 16) * DFF + col0;
                f32x4 v0, v1;
#pragma unroll
                for (int j = 0; j < 4; ++j) { v0[j] = silu_f(acc[ai][0][m][0][j]) * acc[ai][1][m][0][j]; v1[j] = silu_f(acc[ai][0][m][1][j]) * acc[ai][1][m][1][j]; }
                u32x4 w; w.x = cvtpk(v0[0], v0[1]); w.y = cvtpk(v0[2], v0[3]); w.z = cvtpk(v1[0], v1[1]); w.w = cvtpk(v1[2], v1[3]);
                *(u32x4*)rowp = w; }
    }
};
struct EpiResid {
    static constexpr bool PERM = false, CHAIN = false;
    float* out; unsigned char* wsb; const float* basel; int lyr; int modidx; float cs;
    DI void operator()(const f32x4 (&acc)[2][2][4][2], const Unit& u, int wr, int wc, int fr, int fq) const {
        const int br = u.pm < 128 ? (u.pm >> 4) : 8;
        float* hc = (float*)(wsb + WS_HC); float* part = (float*)(wsb + A_PART); const float* modl = (const float*)(wsb + WS_MOD) + (size_t)lyr * 9 * (NMOD * D);
        float* hb = u.pm < 128 ? out + (size_t)u.pm * BM * D : hc + (size_t)(u.pm - 128) * BM * D;
        const int col0 = u.pn * BM + wc * 32 + 4 * fq;
        const float* mp = modl + (size_t)br * (NMOD * D) + modidx * D + col0;
        f32x4 cf[2][2];
#pragma unroll
        for (int bj = 0; bj < 2; ++bj)
#pragma unroll
            for (int n = 0; n < 2; ++n) cf[bj][n] = *(const f32x4*)(mp + bj * HALF + n * 16) * cs;
        if (u.part) {
#pragma unroll
            for (int ai = 0; ai < 2; ++ai)
#pragma unroll
                for (int m = 0; m < 4; ++m) { float* rowp = hb + (size_t)(ai * HALF + wr * 64 + m * 16 + fr) * D + col0;
#pragma unroll
                    for (int bj = 0; bj < 2; ++bj)
#pragma unroll
                        for (int n = 0; n < 2; ++n) { float* p = rowp + bj * HALF + n * 16; *(f32x4*)(part + (size_t)(u.part - 1) * MC * D + (p - hc)) = cf[bj][n] * acc[ai][bj][m][n]; } }
        } else {
            const float* rb = (u.pm < 128) ? basel + (size_t)u.pm * BM * D : hb;
#pragma unroll
            for (int ai = 0; ai < 2; ++ai)
#pragma unroll
                for (int mp = 0; mp < 2; ++mp) { f32x4 hv[2][2][2];
#pragma unroll
                    for (int mm = 0; mm < 2; ++mm) { const float* rowp = rb + (size_t)(ai * HALF + wr * 64 + (2 * mp + mm) * 16 + fr) * D + col0;
#pragma unroll
                        for (int bj = 0; bj < 2; ++bj)
#pragma unroll
                            for (int n = 0; n < 2; ++n) hv[mm][bj][n] = *(const f32x4*)(rowp + bj * HALF + n * 16); }
                    __builtin_amdgcn_sched_barrier(0);
#pragma unroll
                    for (int mm = 0; mm < 2; ++mm) { float* rowp = hb + (size_t)(ai * HALF + wr * 64 + (2 * mp + mm) * 16 + fr) * D + col0;
#pragma unroll
                        for (int bj = 0; bj < 2; ++bj)
#pragma unroll
                            for (int n = 0; n < 2; ++n) *(f32x4*)(rowp + bj * HALF + n * 16) = hv[mm][bj][n] + cf[bj][n] * acc[ai][bj][2 * mp + mm][n]; }
                    __builtin_amdgcn_sched_barrier(0); }
        }
    }
};
struct EpiMerge {
    static constexpr bool PERM = true, CHAIN = true;
    const bf16_t* gates; bf16_t* mm_;
    DI void operator()(f32x4 (&acc)[2][2][4][2], const Unit& u, int wr, int wc, int fr, int fq) const {
        const int row0 = u.pm * BM + wr * 64 + fr, col0 = u.pn * BM + wc * 32 + 8 * fq;
        const bf16_t* gn = gates + (size_t)u.sel * M * D;
        const bf16_t* gd = gates + (size_t)(u.sel < 2 ? u.sel + 1 : 2) * M * D;
        const bool last = u.sel == 2;
#pragma unroll
        for (int ai = 0; ai < 2; ++ai)
#pragma unroll
            for (int mp = 0; mp < 2; ++mp) { u32x4 gnv[2][2], gdv[2][2];
#pragma unroll
                for (int mm = 0; mm < 2; ++mm) { const size_t off = (size_t)(row0 + ai * HALF + (2 * mp + mm) * 16) * D + col0;
#pragma unroll
                    for (int bj = 0; bj < 2; ++bj) { gnv[mm][bj] = *(const u32x4*)(gn + off + bj * HALF); gdv[mm][bj] = gnv[mm][bj]; if (!last) gdv[mm][bj] = *(const u32x4*)(gd + off + bj * HALF); } }
                __builtin_amdgcn_sched_barrier(0);
#pragma unroll
                for (int mm = 0; mm < 2; ++mm) { const size_t off = (size_t)(row0 + ai * HALF + (2 * mp + mm) * 16) * D + col0;
#pragma unroll
                    for (int bj = 0; bj < 2; ++bj) { const u32x4 a = gnv[mm][bj], b = gdv[mm][bj];
                        const float gnum[8] = {bflo(a.x), bfhi(a.x), bflo(a.y), bfhi(a.y), bflo(a.z), bfhi(a.z), bflo(a.w), bfhi(a.w)};
                        const float gden[8] = {bflo(b.x), bfhi(b.x), bflo(b.y), bfhi(b.y), bflo(b.z), bfhi(b.z), bflo(b.w), bfhi(b.w)};
                        f32x4& a0 = acc[ai][bj][2 * mp + mm][0]; f32x4& a1 = acc[ai][bj][2 * mp + mm][1];
                        if (last) {
                            u32x4 w; w.x = cvtpk(gnum[0] * a0[0], gnum[1] * a0[1]); w.y = cvtpk(gnum[2] * a0[2], gnum[3] * a0[3]); w.z = cvtpk(gnum[4] * a1[0], gnum[5] * a1[1]); w.w = cvtpk(gnum[6] * a1[2], gnum[7] * a1[3]);
                            *(u32x4*)(mm_ + off + bj * HALF) = w;
                        } else {
#pragma unroll
                            for (int j = 0; j < 4; ++j) { a0[j] *= gnum[j] * __builtin_amdgcn_rcpf(fmaxf(gden[j], 1e-30f)); a1[j] *= gnum[4 + j] * __builtin_amdgcn_rcpf(fmaxf(gden[4 + j], 1e-30f)); }
                        } } }
                __builtin_amdgcn_sched_barrier(0); }
    }
};

template <class Epi, bool ALIGN_EPI = true>
DI void gemm_phase(int tb_, LAS unsigned char* lds, const Gemm g, const Sched& S, const Epi& E) {
    int tid_ = tb_ + lane_asm(); asm volatile("" : "+v"(tid_));
    const int tid = tid_, wid = __builtin_amdgcn_readfirstlane(tid >> 6), lane = tid & 63, wr = wid >> 2, wc = wid & 3, fr = lane & 15, fq = lane >> 4;
    const int K = g.K;
    unsigned voffA[2], voffB[2];
#pragma unroll
    for (int i = 0; i < 2; ++i) { int R, C; stage_rc(tid * 16 + i * 8192, R, C); const int Rb = Epi::PERM ? ((R & ~31) + perm32(R & 31)) : R;
        voffA[i] = (unsigned)(R * K + C) * 2u; voffB[i] = (unsigned)(Rb * K + C) * 2u; }
    const size_t kstep = (size_t)(BK * 2);
    const size_t hstep = (size_t)HALF * K * 2;
    const size_t tstep = 2 * hstep;
    const unsigned ldsw = (unsigned)wid * 1024u;
    const int aoff = lds_byte(wr * 64 + fr, fq * 8), boff = lds_byte(wc * 32 + fr, fq * 8);
#define PG8_SA(b, h) (((b) * 2 + (h)) * HTB)
#define PG8_SB(b, h) ((4 + (b) * 2 + (h)) * HTB)
#define PG8_STAGE(bufoff, gbase, voff) do { _Pragma("unroll") for (int _i = 0; _i < 2; ++_i) \
        __builtin_amdgcn_global_load_lds((const unsigned*)((const char*)(gbase) + (voff)[_i]), (LAS unsigned*)(lds + (bufoff) + ldsw + _i * 8192), 16, 0, 0); } while (0)
#define PG8_LDA(dst, b, h) do { _Pragma("unroll") for (int m = 0; m < 4; ++m) _Pragma("unroll") for (int k = 0; k < 2; ++k) dst[m][k] = *(const LAS bf16x8*)(lds + PG8_SA(b, h) + aoff + m * 2048 + k * 1024); } while (0)
#define PG8_LDB(dst, b, h) do { _Pragma("unroll") for (int n = 0; n < 2; ++n) _Pragma("unroll") for (int k = 0; k < 2; ++k) dst[n][k] = *(const LAS bf16x8*)(lds + PG8_SB(b, h) + boff + n * 2048 + k * 1024); } while (0)
#define PG8_MMA(ai, bj, At, Bt) do { __builtin_amdgcn_s_setprio(1); _Pragma("unroll") for (int m = 0; m < 4; ++m) _Pragma("unroll") for (int n = 0; n < 2; ++n) _Pragma("unroll") for (int k = 0; k < 2; ++k) \
        acc[ai][bj][m][n] = __builtin_amdgcn_mfma_f32_16x16x32_bf16(Bt[n][k], At[m][k], acc[ai][bj][m][n], 0, 0, 0); __builtin_amdgcn_s_setprio(0); } while (0)
#define PG8_WAIT_V(n) asm volatile("s_waitcnt vmcnt(" #n ")" ::: "memory")
#define PG8_WAIT_L(n) asm volatile("s_waitcnt lgkmcnt(" #n ")" ::: "memory")
#define PG8_BAR __builtin_amdgcn_s_barrier()
#define PG8_SCHED __builtin_amdgcn_sched_barrier(0)
#define PG8_APTR(u) ((const char*)((u).sel == 0 ? g.A0 : ((u).sel == 1 ? g.A1 : g.A2)) + (size_t)(u).pm * tstep + (size_t)(u).kt0 * kstep)
#define PG8_BPTR(u) ((const char*)((u).sel == 0 ? g.B0 : ((u).sel == 1 ? g.B1 : g.B2)) + (size_t)(u).pn * tstep + (size_t)(u).kt0 * kstep)
    Unit cur, nxt; int ui = 0;
    if (!S.next(0, cur)) return;
    f32x4 acc[2][2][4][2];
#pragma unroll
    for (int a = 0; a < 2; ++a)
#pragma unroll
        for (int b = 0; b < 2; ++b)
#pragma unroll
            for (int m = 0; m < 4; ++m)
#pragma unroll
                for (int n = 0; n < 2; ++n) acc[a][b][m][n] = (f32x4){0.f, 0.f, 0.f, 0.f};
    bf16x8 At[4][2], B0[2][2], B1[2][2];
    const char* cA = PG8_APTR(cur); const char* cB = PG8_BPTR(cur);
    PG8_STAGE(PG8_SB(0, 0), cB, voffB); PG8_STAGE(PG8_SB(0, 1), cB + hstep, voffB); PG8_STAGE(PG8_SA(0, 0), cA, voffA); PG8_STAGE(PG8_SA(0, 1), cA + hstep, voffA);
    if (wr == 1) PG8_BAR;
    PG8_WAIT_V(2); PG8_BAR;
    PG8_STAGE(PG8_SB(1, 0), cB + kstep, voffB); PG8_STAGE(PG8_SA(1, 0), cA + kstep, voffA); PG8_STAGE(PG8_SB(1, 1), cB + hstep + kstep, voffB);
    PG8_WAIT_V(6); PG8_BAR;
    for (;;) {
        const bool has_next = S.next(ui + 1, nxt);
        const char* nA = has_next ? PG8_APTR(nxt) : cA; const char* nB = has_next ? PG8_BPTR(nxt) : cB;
        const int nt = cur.nt;
        for (int t = 0; t < nt; t += 2) {
            const bool last = (t == nt - 2);
            const char* a1 = cA + (size_t)(t + 1) * kstep;
            const char* a2 = last ? nA : cA + (size_t)(t + 2) * kstep; const char* b2 = last ? nB : cB + (size_t)(t + 2) * kstep;
            const char* a3 = a2 + kstep; const char* b3 = b2 + kstep;
            PG8_LDB(B0, 0, 0); PG8_LDB(B1, 0, 1); PG8_SCHED; PG8_LDA(At, 0, 0); PG8_STAGE(PG8_SA(1, 1), a1 + hstep, voffA);
            PG8_WAIT_V(8); PG8_WAIT_L(0); PG8_BAR; PG8_MMA(0, 0, At, B0); PG8_MMA(0, 1, At, B1); PG8_BAR; PG8_SCHED;
            PG8_LDA(At, 0, 1); PG8_STAGE(PG8_SB(0, 0), b2, voffB); PG8_STAGE(PG8_SB(0, 1), b2 + hstep, voffB); PG8_STAGE(PG8_SA(0, 0), a2, voffA);
            PG8_WAIT_V(8); PG8_WAIT_L(0); PG8_BAR; PG8_MMA(1, 0, At, B0); PG8_MMA(1, 1, At, B1); PG8_BAR; PG8_SCHED;
            PG8_LDB(B0, 1, 0); PG8_LDB(B1, 1, 1); PG8_SCHED; PG8_LDA(At, 1, 0); PG8_STAGE(PG8_SA(0, 1), a2 + hstep, voffA);
            PG8_WAIT_V(8); PG8_WAIT_L(0); PG8_BAR; PG8_MMA(0, 0, At, B0); PG8_MMA(0, 1, At, B1); PG8_BAR; PG8_SCHED;
            PG8_LDA(At, 1, 1); PG8_STAGE(PG8_SB(1, 0), b3, voffB); PG8_STAGE(PG8_SB(1, 1), b3 + hstep, voffB); PG8_STAGE(PG8_SA(1, 0), a3, voffA);
            PG8_WAIT_V(8); PG8_WAIT_L(0); PG8_BAR; PG8_MMA(1, 0, At, B0); PG8_MMA(1, 1, At, B1); PG8_BAR; PG8_SCHED;
        }
        if constexpr (ALIGN_EPI) { if (wr == 0) PG8_BAR; }
        E(acc, cur, wr, wc, fr, fq);
        if (!has_next) break;
        bool keep = false;
        if constexpr (Epi::CHAIN) keep = cur.sel != 2;
        if (!keep) {
#pragma unroll
        for (int a = 0; a < 2; ++a)
#pragma unroll
            for (int b = 0; b < 2; ++b)
#pragma unroll
                for (int m = 0; m < 4; ++m)
#pragma unroll
                    for (int n = 0; n < 2; ++n) acc[a][b][m][n] = (f32x4){0.f, 0.f, 0.f, 0.f};
        }
        cur = nxt; cA = nA; cB = nB; ++ui;
        if constexpr (ALIGN_EPI) { if (wr == 1) PG8_BAR; }
    }
    PG8_WAIT_V(0);
    if constexpr (!ALIGN_EPI) { if (wr == 0) PG8_BAR; }
    PG8_BAR;
#undef PG8_SA
#undef PG8_SB
#undef PG8_STAGE
#undef PG8_LDA
#undef PG8_LDB
#undef PG8_MMA
#undef PG8_WAIT_V
#undef PG8_WAIT_L
#undef PG8_BAR
#undef PG8_SCHED
#undef PG8_APTR
#undef PG8_BPTR
}
}

#ifndef REPMASK
#define REPMASK 0
#endif
#define REPN(bit) (1 + ((REPMASK >> (bit)) & 1))
constexpr int NWAVES = 8, NTHR = 512;
constexpr int LDS_BYTES = 147456;
struct Args { const float* in[29]; float* out; unsigned char* ws; int ph_lo, ph_hi; };
typedef const __attribute__((address_space(4))) Args* ArgsP;
enum { I_X = 0, I_C, I_CTX, I_CCTX, I_WADA, I_BADA, I_GFFN1, I_F1W1, I_F1W3, I_F1W2, I_GMIX, I_WIN, I_GCQ, I_WUQ, I_GCKV, I_WUKV, I_GQN, I_GKN, I_WPOOL, I_PSCALE,
       I_WA2, I_BA2, I_GGLA, I_WBR, I_WOUT, I_GFFN2, I_F2W1, I_F2W3, I_F2W2 };

DI void tr_item(const float* W, int ld, int col0, bf16_t* WT, int pitch, int k_off, int row_off, int mode, const float* ks, const float* ns, int nblk, int item, float* scr, int lane) {
    const int kb = item / nblk, nb = item % nblk, k0 = 64 * kb, n0 = 32 * nb;
    { const int n4 = (lane & 7) * 4; f32x4 wv[8];
#pragma unroll
      for (int i = 0; i < 8; ++i) wv[i] = *(const f32x4*)(W + (size_t)(k0 + 8 * i + (lane >> 3)) * ld + col0 + n0 + n4);
#pragma unroll
      for (int i = 0; i < 8; ++i) { const int kk = 8 * i + (lane >> 3); f32x4 v = wv[i]; if (ks) v = v * ks[k0 + kk];
          float* d = scr + kk * 33 + n4; d[0] = v.x; d[1] = v.y; d[2] = v.z; d[3] = v.w; } }
    __builtin_amdgcn_s_waitcnt(0); asm volatile("" ::: "memory");
    const int c = lane & 7;
#pragma unroll
    for (int j = 0; j < 4; ++j) { const int n = (lane >> 3) + 8 * j; const float* s = scr + (8 * c) * 33 + n;
        const int nn = n0 + n; const int drow = mode ? (256 * (nn >> 7) + (nn & 127) + row_off) : (row_off + nn);
        const float sc = ns ? ns[drow] : 1.f;
        u32x4 o; o.x = cvtpk(s[0 * 33] * sc, s[1 * 33] * sc); o.y = cvtpk(s[2 * 33] * sc, s[3 * 33] * sc); o.z = cvtpk(s[4 * 33] * sc, s[5 * 33] * sc); o.w = cvtpk(s[6 * 33] * sc, s[7 * 33] * sc);
        *(u32x4*)(WT + (size_t)drow * pitch + k_off + k0 + 8 * c) = o; }
    __builtin_amdgcn_s_waitcnt(0); asm volatile("" ::: "memory");
}
#define TRJOB(W_, K_, ld_, col0_, ncols_, WT_, pitch_, koff_, rowoff_, mode_, ks_, ns_) do { const int nblk_ = (ncols_) / 32, nit_ = ((K_) / 64) * nblk_; \
    for (int it = gw; it < nit_; it += NGW) tr_item(W_, ld_, col0_, WT_, pitch_, koff_, rowoff_, mode_, ks_, ns_, nblk_, it, scr, lane); } while (0)

DI void phase_convert(ArgsP a, int tb_, int l, char* shm, int vcu, int G) {
    int tid_ = tb_ + lane_asm(); asm volatile("" : "+v"(tid_)); const int tid = tid_, lane = tid & 63, wave = tid >> 6;
    float* scr = (float*)(shm + wave * 8704);
    const int gw = vcu * NWAVES + wave, NGW = G * NWAVES;
    unsigned char* W = a->ws + WS_W;
    bf16_t* w13a = (bf16_t*)(W + W_13A); bf16_t* w2a = (bf16_t*)(W + W_2A); bf16_t* w13b = (bf16_t*)(W + W_13B); bf16_t* w2b = (bf16_t*)(W + W_2B);
    bf16_t* win = (bf16_t*)(W + W_IN); bf16_t* wuq = (bf16_t*)(W + W_UQ); bf16_t* wukv = (bf16_t*)(W + W_UKV); bf16_t* wpool = (bf16_t*)(W + W_POOL);
    bf16_t* wbr = (bf16_t*)(W + W_BR); bf16_t* wout = (bf16_t*)(W + W_OUT);
    const size_t fsz = (size_t)D * DFF;
    TRJOB(a->in[I_F1W1] + l * fsz, D, DFF, 0, DFF, w13a, D, 0, 0, 1, nullptr, nullptr);
    TRJOB(a->in[I_F1W3] + l * fsz, D, DFF, 0, DFF, w13a, D, 0, 128, 1, nullptr, nullptr);
    TRJOB(a->in[I_F1W2] + l * fsz, DFF, D, 0, D, w2a, DFF, 0, 0, 0, nullptr, nullptr);
    TRJOB(a->in[I_F2W1] + l * fsz, D, DFF, 0, DFF, w13b, D, 0, 0, 1, nullptr, nullptr);
    TRJOB(a->in[I_F2W3] + l * fsz, D, DFF, 0, DFF, w13b, D, 0, 128, 1, nullptr, nullptr);
    TRJOB(a->in[I_F2W2] + l * fsz, DFF, D, 0, D, w2b, DFF, 0, 0, 0, nullptr, nullptr);
    const float* wi = a->in[I_WIN] + (size_t)l * D * DIN;
    TRJOB(wi, D, DIN, 0, 416, win, D, 0, 0, 0, nullptr, nullptr);
    TRJOB(wi, D, DIN, 416, 1536, win, D, 0, 512, 0, nullptr, nullptr);
    TRJOB(wi, D, DIN, 1984, 512, win, D, 0, 2048, 0, nullptr, nullptr);
    TRJOB(wi, D, DIN, 1952, 32, win, D, 0, 2560, 0, nullptr, nullptr);
    TRJOB(wi, D, DIN, 2496, 3072, win, D, 0, 2816, 0, nullptr, nullptr);
    TRJOB(a->in[I_WUQ] + (size_t)l * 256 * 768, 256, 768, 0, 768, wuq, 256, 0, 0, 0, a->in[I_GCQ] + l * 256, nullptr);
    TRJOB(a->in[I_WUKV] + (size_t)l * 128 * 1024, 128, 1024, 0, 1024, wukv, 256, 0, 0, 0, a->in[I_GCKV] + l * 128, nullptr);
    for (int g = 0; g < 4; ++g) TRJOB(a->in[I_WPOOL] + (size_t)(l * 4 + g) * 128 * 128, 128, 128, 0, 128, wpool, 512, 128 * g, 128 * g, 0, nullptr, a->in[I_PSCALE] + l * 512);
    for (int i = 0; i < 3; ++i) TRJOB(a->in[I_WBR] + (size_t)(l * 3 + i) * 512 * 1024, 512, 1024, 0, 1024, wbr + (size_t)i * 1024 * 512, 512, 0, 0, 0, nullptr, nullptr);
    TRJOB(a->in[I_WOUT] + (size_t)l * D * D, D, D, 0, D, wout, D, 0, 0, 0, nullptr, nullptr);
    const int gt = vcu * NTHR + tid, NGT = G * NTHR; u32x4 z; asm volatile("v_mov_b32 %0, 0\n\tv_mov_b32 %1, 0\n\tv_mov_b32 %2, 0\n\tv_mov_b32 %3, 0" : "=v"(z.x), "=v"(z.y), "=v"(z.z), "=v"(z.w));
    if (l == 0) { float* rope = (float*)(a->ws + WS_ROPE);
        for (int i = gt; i < SEQ * 16; i += NGT) { const int t = i >> 4, af = i & 15, f = af & 7; const float inv = powf(10000.f, -(float)(2 * f) / 16.f);
            float sv, cv; sincosf((float)((af >> 3) ? (t & 63) : (t >> 6)) * inv, &sv, &cv); rope[t * 32 + af] = cv; rope[t * 32 + 16 + af] = sv; } }
    for (int i = gt; i < 96 * 128; i += NGT) *(u32x4*)(win + (size_t)(416 + i / 128) * D + (i % 128) * 8) = z;
    for (int i = gt; i < 224 * 128; i += NGT) *(u32x4*)(win + (size_t)(2592 + i / 128) * D + (i % 128) * 8) = z;
    for (int i = gt; i < 1024 * 16; i += NGT) *(u32x4*)(wukv + (size_t)(i / 16) * 256 + 128 + (i % 16) * 8) = z;
    for (int i = gt; i < 512 * 64; i += NGT) { const int r = i / 64, kc = i % 64; if ((kc >> 4) != (r >> 7)) *(u32x4*)(wpool + (size_t)r * 512 + kc * 8) = z; }
}

DI void phase_mod(ArgsP a, int tb_, char* shm, int vcu, int G) {
    int tid_ = tb_ + lane_asm(); asm volatile("" : "+v"(tid_)); const int tid = tid_, lane = tid & 63, wave = tid >> 6;
    float* sc = (float*)shm;
    float* part = (float*)(shm + 9 * 1024 * 4);
    for (int i = tid; i < 9 * D; i += NTHR) { const float v = i < 8 * D ? a->in[I_C][i] : a->in[I_CCTX][i - 8 * D]; sc[i] = silu_f(v); }
    __syncthreads();
    float* mod = (float*)(a->ws + WS_MOD);
    for (int it = vcu; it < 2 * 144; it += G) {
        const int l = it / 144, n0 = (it % 144) * 64;
        const float* w = a->in[I_WADA] + (size_t)l * D * (NMOD * D) + n0 + lane;
        float s[9];
#pragma unroll
        for (int r = 0; r < 9; ++r) s[r] = 0.f;
        const int kb = wave * 128;
#pragma unroll 4
        for (int k = 0; k < 128; ++k) { const float wv = w[(size_t)(kb + k) * (NMOD * D)];
#pragma unroll
            for (int r = 0; r < 9; ++r) s[r] += sc[r * D + kb + k] * wv; }
#pragma unroll
        for (int r = 0; r < 9; ++r) part[(wave * 9 + r) * 64 + lane] = s[r];
        __syncthreads();
        for (int i = tid; i < 9 * 64; i += NTHR) { const int r = i / 64, n = i % 64; float t = a->in[I_BADA][(size_t)l * (NMOD * D) + n0 + n];
#pragma unroll
            for (int w8 = 0; w8 < 8; ++w8) t += part[(w8 * 9 + r) * 64 + n];
            mod[((size_t)l * 9 + r) * (NMOD * D) + n0 + n] = t; }
        __syncthreads();
    }
}

DI void phase_normmod(ArgsP a, int tb_, int l, int which, bool first, bool addp, bool ctx0, int MR, int vcu, int G) {
    int tid_ = tb_ + lane_asm(); asm volatile("" : "+v"(tid_)); const int tid = tid_, lane = tid & 63, wave = tid >> 6;
    const int gw = vcu * NWAVES + wave, NGW = G * NWAVES;
    const float* g = (which == 0 ? a->in[I_GFFN1] : which == 1 ? a->in[I_GMIX] : a->in[I_GFFN2]) + l * D;
    const float* mod = (const float*)(a->ws + WS_MOD) + (size_t)l * 9 * (NMOD * D);
    float* hc = (float*)(a->ws + WS_HC); bf16_t* U = (bf16_t*)(a->ws + WS_U);
#define NM_SRC(mm) (first ? ((mm) < ML ? a->in[I_X] + (size_t)(mm) * D : a->in[I_CTX] + (size_t)((mm) - ML) * D) : ((mm) < ML ? a->out + (size_t)(mm) * D : (ctx0 ? a->in[I_CTX] + (size_t)((mm) - ML) * D : hc + (size_t)((mm) - ML) * D)))
    f32x4 nv[4];
    if (gw < MR) { const f32x4* xr = (const f32x4*)NM_SRC(gw) + lane;
#pragma unroll
        for (int j = 0; j < 4; ++j) nv[j] = xr[64 * j]; }
    for (int m = gw; m < MR; m += NGW) {
        const int br = m < ML ? (m >> 12) : 8;
        float* hrow = m < ML ? a->out + (size_t)m * D : hc + (size_t)(m - ML) * D;
        f32x4 v[4]; float s = 0.f;
#pragma unroll
        for (int j = 0; j < 4; ++j) v[j] = nv[j];
        { const int mn = m + NGW; if (mn < MR) { const f32x4* xr = (const f32x4*)NM_SRC(mn) + lane;
#pragma unroll
            for (int j = 0; j < 4; ++j) nv[j] = xr[64 * j]; } }
        const f32x4* gp = (const f32x4*)g + lane; const f32x4* sh = (const f32x4*)(mod + (size_t)br * (NMOD * D) + (3 * which) * D) + lane; const f32x4* scp = (const f32x4*)(mod + (size_t)br * (NMOD * D) + (3 * which + 1) * D) + lane;
        f32x4 gv[4], sv[4], cv[4];
#pragma unroll
        for (int j = 0; j < 4; ++j) { gv[j] = gp[64 * j]; sv[j] = sh[64 * j]; cv[j] = scp[64 * j] + 1.f; }
#pragma unroll
        for (int j = 0; j < 4; ++j) s += (v[j].x * v[j].x + v[j].y * v[j].y) + (v[j].z * v[j].z + v[j].w * v[j].w);
        if (addp && m >= ML) { const f32x4* pp = (const f32x4*)((const float*)(a->ws + A_PART) + (size_t)(m - ML) * D) + lane; s = 0.f;
#pragma unroll
            for (int jh = 0; jh < 2; ++jh) { f32x4 pv[2][8];
#pragma unroll
                for (int jj = 0; jj < 2; ++jj)
#pragma unroll
                    for (int p = 0; p < 8; ++p) pv[jj][p] = pp[(size_t)p * MC * (D / 4) + 64 * (2 * jh + jj)];
                __builtin_amdgcn_sched_barrier(0);
#pragma unroll
                for (int jj = 0; jj < 2; ++jj) { const int j = 2 * jh + jj;
#pragma unroll
                    for (int p = 0; p < 8; ++p) v[j] = v[j] + pv[jj][p];
                    s += (v[j].x * v[j].x + v[j].y * v[j].y) + (v[j].z * v[j].z + v[j].w * v[j].w); } } }
        if (addp && m >= ML) {
#pragma unroll
            for (int j = 0; j < 4; ++j) ((f32x4*)hrow + lane)[64 * j] = v[j]; }
        const float r = rsqrtf(wave_sum(s, lane) * (1.f / D) + EPS);
        u32x2* o = (u32x2*)(U + (size_t)m * D) + lane;
#pragma unroll
        for (int j = 0; j < 4; ++j) { const f32x4 y = v[j] * r * gv[j]; const f32x4 u = y * cv[j] + sv[j]; u32x2 w; w.x = cvtpk(u.x, u.y); w.y = cvtpk(u.z, u.w); o[64 * j] = w; }
    }
#undef NM_SRC
}

DI void phase_mla_fin(ArgsP a, int tb_, int l, char* shm, int vcu, int G) {
    int tid_ = tb_ + lane_asm(); asm volatile("" : "+v"(tid_)); const int tid = tid_, lane = tid & 63, wave = tid >> 6;
    const int gw = vcu * NWAVES + wave, NGW = G * NWAVES;
    const bf16_t* zcq = (const bf16_t*)(a->ws + A_ZCQ); const bf16_t* zkv = (const bf16_t*)(a->ws + A_ZKV);
    const bf16_t* qraw = (const bf16_t*)(a->ws + A_QRAW); const bf16_t* kvraw = (const bf16_t*)(a->ws + A_KVRAW);
    bf16_t* Qb = (bf16_t*)(a->ws + A_Q); bf16_t* Kb = (bf16_t*)(a->ws + A_K); bf16_t* Vt = (bf16_t*)(a->ws + A_VT);
    const float* gqn0 = a->in[I_GQN] + l * 96; const float* gkn0 = a->in[I_GKN] + l * 96;
#define UNPK(W_, E_) const float E_[8] = {bflo((W_).x), bfhi((W_).x), bflo((W_).y), bfhi((W_).y), bflo((W_).z), bfhi((W_).z), bflo((W_).w), bfhi((W_).w)}
#define SSQ8(W_, ACC_) do { UNPK(W_, e_); ACC_ += (e_[0] * e_[0] + e_[1] * e_[1]) + (e_[2] * e_[2] + e_[3] * e_[3]) + (e_[4] * e_[4] + e_[5] * e_[5]) + (e_[6] * e_[6] + e_[7] * e_[7]); } while (0)
#define ROPE32(xr) _Pragma("unroll") for (int ax = 0; ax < 2; ++ax) _Pragma("unroll") for (int f = 0; f < 8; ++f) { const float x1 = xr[16 * ax + f], x2 = xr[16 * ax + 8 + f], c = cs[8 * ax + f], sv = sn[8 * ax + f]; xr[16 * ax + f] = x1 * c - x2 * sv; xr[16 * ax + 8 + f] = x2 * c + x1 * sv; }
    for (int it = gw; it < (M / 8) * 2; it += NGW) {
        const int m = (it >> 1) * 8 + (lane >> 3), h = lane & 7;
        const bool lat = m < ML; const int t = lat ? (m & 4095) : ((m - ML) & 255); const int b = lat ? (m >> 12) : ((m - ML) >> 8); const int pos = lat ? LC + t : t;
        const size_t bh = (size_t)(b * 8 + h);
        const f32x4* rp = (const f32x4*)((const float*)(a->ws + WS_ROPE) + (size_t)(lat ? t : 0) * 32);
        f32x4 rc[4], rs[4];
#pragma unroll
        for (int i = 0; i < 4; ++i) { rc[i] = rp[i]; rs[i] = rp[4 + i]; }
        if (!(it & 1)) {
            const u32x4* ps = (const u32x4*)(zcq + (size_t)m * 256) + 4 * h; const u32x4* p = (const u32x4*)(qraw + (size_t)m * 768 + h * 96);
            u32x4 st[4], w[12];
#pragma unroll
            for (int i = 0; i < 4; ++i) st[i] = ps[i];
#pragma unroll
            for (int i = 0; i < 12; ++i) w[i] = p[i];
            const float* gqn = gqn0; asm volatile("" : "+s"(gqn));
            float cs[16], sn[16];
#pragma unroll
            for (int i = 0; i < 4; ++i) { cs[4 * i] = lat ? rc[i].x : 1.f; cs[4 * i + 1] = lat ? rc[i].y : 1.f; cs[4 * i + 2] = lat ? rc[i].z : 1.f; cs[4 * i + 3] = lat ? rc[i].w : 1.f;
                sn[4 * i] = lat ? rs[i].x : 0.f; sn[4 * i + 1] = lat ? rs[i].y : 0.f; sn[4 * i + 2] = lat ? rs[i].z : 0.f; sn[4 * i + 3] = lat ? rs[i].w : 0.f; }
            float ssq = 0.f, ss = 0.f;
#pragma unroll
            for (int i = 0; i < 4; ++i) SSQ8(st[i], ssq);
            ssq += shx(ssq, 1, lane); ssq += shx(ssq, 2, lane); ssq += shx(ssq, 4, lane);
            const float rq = rsqrtf(ssq * (1.f / 256.f) + EPS);
#pragma unroll
            for (int i = 0; i < 12; ++i) SSQ8(w[i], ss);
            const float rn = rsqrtf(ss * rq * rq * (1.f / 96.f) + EPS) * rq;
            u32x4* o = (u32x4*)(Qb + (bh * KVLEN + pos) * 96);
#pragma unroll
            for (int i = 0; i < 8; ++i) { UNPK(w[i], e); const float sc = rn * C2; u32x4 ow;
                ow.x = cvtpk(e[0] * sc * gqn[8 * i], e[1] * sc * gqn[8 * i + 1]); ow.y = cvtpk(e[2] * sc * gqn[8 * i + 2], e[3] * sc * gqn[8 * i + 3]);
                ow.z = cvtpk(e[4] * sc * gqn[8 * i + 4], e[5] * sc * gqn[8 * i + 5]); ow.w = cvtpk(e[6] * sc * gqn[8 * i + 6], e[7] * sc * gqn[8 * i + 7]); o[i] = ow; }
            float xr[32];
#pragma unroll
            for (int i = 0; i < 4; ++i) { UNPK(w[8 + i], e);
#pragma unroll
                for (int j = 0; j < 8; ++j) xr[8 * i + j] = e[j] * rn * C2 * gqn[64 + 8 * i + j]; }
            ROPE32(xr)
#pragma unroll
            for (int i = 0; i < 4; ++i) { u32x4 ow; ow.x = cvtpk(xr[8 * i], xr[8 * i + 1]); ow.y = cvtpk(xr[8 * i + 2], xr[8 * i + 3]); ow.z = cvtpk(xr[8 * i + 4], xr[8 * i + 5]); ow.w = cvtpk(xr[8 * i + 6], xr[8 * i + 7]); o[8 + i] = ow; }
        } else {
            const u32x4* pz = (const u32x4*)(zkv + (size_t)m * 256); const u32x4* p = (const u32x4*)(kvraw + (size_t)m * 1024 + h * 128);
            u32x4 st[2], krp[4], w[8], vw[8];
#pragma unroll
            for (int i = 0; i < 2; ++i) st[i] = pz[2 * h + i];
#pragma unroll
            for (int i = 0; i < 4; ++i) krp[i] = pz[16 + i];
#pragma unroll
            for (int i = 0; i < 8; ++i) { w[i] = p[i]; vw[i] = p[8 + i]; }
            const float* gkn = gkn0; asm volatile("" : "+s"(gkn));
            float sskv = 0.f, ss = 0.f, sk = 0.f;
#pragma unroll
            for (int i = 0; i < 2; ++i) SSQ8(st[i], sskv);
            sskv += shx(sskv, 1, lane); sskv += shx(sskv, 2, lane); sskv += shx(sskv, 4, lane);
            const float rkv = rsqrtf(sskv * (1.f / 128.f) + EPS);
            { bf16_t* vo = Vt + bh * 64 * KVLEN + pos;
#pragma unroll
              for (int i = 0; i < 8; ++i) { UNPK(vw[i], e);
#pragma unroll
                  for (int j = 0; j < 8; ++j) vo[(size_t)(8 * i + j) * KVLEN] = f2bf(e[j] * rkv); } }
#pragma unroll
            for (int i = 0; i < 8; ++i) SSQ8(w[i], ss);
#pragma unroll
            for (int i = 0; i < 4; ++i) SSQ8(krp[i], sk);
            const float rn = rsqrtf((ss * rkv * rkv + sk) * (1.f / 96.f) + EPS);
            u32x4* o = (u32x4*)(Kb + (bh * KVLEN + pos) * 96);
#pragma unroll
            for (int i = 0; i < 8; ++i) { UNPK(w[i], e); const float sc = rn * rkv; u32x4 ow;
                ow.x = cvtpk(e[0] * sc * gkn[8 * i], e[1] * sc * gkn[8 * i + 1]); ow.y = cvtpk(e[2] * sc * gkn[8 * i + 2], e[3] * sc * gkn[8 * i + 3]);
                ow.z = cvtpk(e[4] * sc * gkn[8 * i + 4], e[5] * sc * gkn[8 * i + 5]); ow.w = cvtpk(e[6] * sc * gkn[8 * i + 6], e[7] * sc * gkn[8 * i + 7]); o[i] = ow; }
            float cs[16], sn[16];
#pragma unroll
            for (int i = 0; i < 4; ++i) { cs[4 * i] = lat ? rc[i].x : 1.f; cs[4 * i + 1] = lat ? rc[i].y : 1.f; cs[4 * i + 2] = lat ? rc[i].z : 1.f; cs[4 * i + 3] = lat ? rc[i].w : 1.f;
                sn[4 * i] = lat ? rs[i].x : 0.f; sn[4 * i + 1] = lat ? rs[i].y : 0.f; sn[4 * i + 2] = lat ? rs[i].z : 0.f; sn[4 * i + 3] = lat ? rs[i].w : 0.f; }
            float xr[32];
#pragma unroll
            for (int i = 0; i < 4; ++i) { UNPK(krp[i], e);
#pragma unroll
                for (int j = 0; j < 8; ++j) xr[8 * i + j] = e[j] * rn * gkn[64 + 8 * i + j]; }
            ROPE32(xr)
#pragma unroll
            for (int i = 0; i < 4; ++i) { u32x4 ow; ow.x = cvtpk(xr[8 * i], xr[8 * i + 1]); ow.y = cvtpk(xr[8 * i + 2], xr[8 * i + 3]); ow.z = cvtpk(xr[8 * i + 4], xr[8 * i + 5]); ow.w = cvtpk(xr[8 * i + 6], xr[8 * i + 7]); o[8 + i] = ow; }
        }
    }
#undef UNPK
#undef SSQ8
#undef ROPE32
}

constexpr int AT_KP = 208, AT_VP = 136;
constexpr int AT_KB = 64 * AT_KP, AT_VB = 64 * AT_VP;
DI void attn_unit(int tb_, char* shm, const bf16_t* Qp, const bf16_t* Kp, const bf16_t* Vtp, int nkeys, int nrows, bf16_t* Op) {
    int tid_ = tb_ + lane_asm(); asm volatile("" : "+v"(tid_)); const int tid = tid_, lane = tid & 63, r32 = lane & 31, hi = lane >> 5, wid = __builtin_amdgcn_readfirstlane(tid >> 6);
    char* Kl = shm; char* Vl = shm + 2 * AT_KB; float* wsf = (float*)(shm + 2 * AT_KB + 2 * AT_VB) + wid * 32;
    const bool act = wid * 64 < nrows;
    bf16x8 qf0[6], qf1[6];
    { const bf16_t* qrow = Qp + (size_t)((act ? wid * 64 : 0) + r32) * 96 + hi * 8;
#pragma unroll
      for (int s = 0; s < 6; ++s) { qf0[s] = *(const bf16x8*)(qrow + 16 * s); qf1[s] = *(const bf16x8*)(qrow + 32 * 96 + 16 * s); } }
    const int kkey0 = tid / 12, kc0 = tid % 12, kkey1 = (tid + 512) / 12, kc1 = (tid + 512) % 12; const bool k1ok = tid < 256;
    const int vd = tid >> 3, vc = tid & 7;
    u32x4 kr0, kr1, vr; kr1 = (u32x4){0u, 0u, 0u, 0u};
#define AT_LOAD(t) do { kr0 = *(const u32x4*)(Kp + (size_t)((t) * 64 + kkey0) * 96 + kc0 * 8); if (k1ok) kr1 = *(const u32x4*)(Kp + (size_t)((t) * 64 + kkey1) * 96 + kc1 * 8); \
        vr = *(const u32x4*)(Vtp + (size_t)vd * KVLEN + (t) * 64 + vc * 8); } while (0)
#define AT_STORE(bf) do { *(u32x4*)(Kl + (bf) * AT_KB + kkey0 * AT_KP + kc0 * 16) = kr0; if (k1ok) *(u32x4*)(Kl + (bf) * AT_KB + kkey1 * AT_KP + kc1 * 16) = kr1; \
        *(u32x2*)(Vl + (bf) * AT_VB + vd * AT_VP + vc * 16) = (u32x2){vr.x, vr.y}; *(u32x2*)(Vl + (bf) * AT_VB + vd * AT_VP + vc * 16 + 8) = (u32x2){vr.z, vr.w}; } while (0)
#define MAX3(a_, b_, c_) ({ float r_; asm("v_max3_f32 %0, %1, %2, %3" : "=v"(r_) : "v"(a_), "v"(b_), "v"(c_)); r_; })
#define AT_SM(P0, P1, O0, O1, MR, LS, PA) do { \
        float mt = MAX3(P0[0], P0[1], P1[0]); mt = MAX3(mt, P1[1], P0[2]); \
        _Pragma("unroll") for (int r = 2; r < 16; r += 2) { mt = MAX3(mt, P0[r], P0[r + 1]); mt = MAX3(mt, P1[r], P1[r + 1]); } \
        mt = fmaxf(mt, shx(mt, 32, lane)); \
        if (__any(mt > MR + 8.f)) { \
            const float mnew = fmaxf(MR, mt); const float f = __builtin_amdgcn_exp2f(MR - mnew); LS *= f; MR = mnew; \
            if (hi == 0) wsf[r32] = f; \
            asm volatile("s_waitcnt lgkmcnt(0)" ::: "memory"); \
            _Pragma("unroll") for (int r = 0; r < 16; ++r) { const float fr = wsf[crow(r, hi)]; O0[r] *= fr; O1[r] *= fr; } \
        } \
        float ps = 0.f; \
        _Pragma("unroll") for (int r = 0; r < 16; ++r) { P0[r] = __builtin_amdgcn_exp2f(P0[r] - MR); P1[r] = __builtin_amdgcn_exp2f(P1[r] - MR); ps += P0[r]; ps += P1[r]; } \
        LS += ps; \
        _Pragma("unroll") for (int s2 = 0; s2 < 2; ++s2) { \
            u32x4 w; w.x = cvtpk(P0[8 * s2], P0[8 * s2 + 1]); w.y = cvtpk(P0[8 * s2 + 2], P0[8 * s2 + 3]); w.z = cvtpk(P0[8 * s2 + 4], P0[8 * s2 + 5]); w.w = cvtpk(P0[8 * s2 + 6], P0[8 * s2 + 7]); PA[s2] = __builtin_bit_cast(bf16x8, w); \
            u32x4 w2; w2.x = cvtpk(P1[8 * s2], P1[8 * s2 + 1]); w2.y = cvtpk(P1[8 * s2 + 2], P1[8 * s2 + 3]); w2.z = cvtpk(P1[8 * s2 + 4], P1[8 * s2 + 5]); w2.w = cvtpk(P1[8 * s2 + 6], P1[8 * s2 + 7]); PA[2 + s2] = __builtin_bit_cast(bf16x8, w2); } } while (0)
    const int nt = nkeys >> 6;
    f32x16 oa0, oa1, ob0, ob1;
#pragma unroll
    for (int r = 0; r < 16; ++r) { oa0[r] = 0.f; oa1[r] = 0.f; ob0[r] = 0.f; ob1[r] = 0.f; }
    float mra = -INFINITY, lsa = 0.f, mrb = -INFINITY, lsb = 0.f;
    AT_LOAD(0); AT_STORE(0); __syncthreads();
    for (int t = 0; t < nt; ++t) {
        const int bf = t & 1;
        if (t + 1 < nt) AT_LOAD(t + 1);
        if (act) {
            f32x16 pa0, pa1, pb0, pb1;
#pragma unroll
            for (int r = 0; r < 16; ++r) { pa0[r] = 0.f; pa1[r] = 0.f; pb0[r] = 0.f; pb1[r] = 0.f; }
            const char* kb = Kl + bf * AT_KB + r32 * AT_KP + 16 * hi;
#pragma unroll
            for (int s = 0; s < 6; ++s) { const bf16x8 k0 = *(const bf16x8*)(kb + 32 * s); const bf16x8 k1 = *(const bf16x8*)(kb + 32 * AT_KP + 32 * s);
                pa0 = __builtin_amdgcn_mfma_f32_32x32x16_bf16(k0, qf0[s], pa0, 0, 0, 0); pa1 = __builtin_amdgcn_mfma_f32_32x32x16_bf16(k1, qf0[s], pa1, 0, 0, 0);
                pb0 = __builtin_amdgcn_mfma_f32_32x32x16_bf16(k0, qf1[s], pb0, 0, 0, 0); pb1 = __builtin_amdgcn_mfma_f32_32x32x16_bf16(k1, qf1[s], pb1, 0, 0, 0); }
            bf16x8 qa[4], qb4[4];
            AT_SM(pa0, pa1, oa0, oa1, mra, lsa, qa);
            AT_SM(pb0, pb1, ob0, ob1, mrb, lsb, qb4);
            __builtin_amdgcn_sched_barrier(0);
            const char* vb = Vl + bf * AT_VB + r32 * AT_VP + 8 * hi;
#pragma unroll
            for (int kh = 0; kh < 2; ++kh) {
                u32x2 va0[2], va1[2], vc0[2], vc1[2];
#pragma unroll
                for (int k2 = 0; k2 < 2; ++k2) { const int ks = 2 * kh + k2; va0[k2] = *(const u32x2*)(vb + 32 * ks); va1[k2] = *(const u32x2*)(vb + 32 * ks + 16); vc0[k2] = *(const u32x2*)(vb + 32 * AT_VP + 32 * ks); vc1[k2] = *(const u32x2*)(vb + 32 * AT_VP + 32 * ks + 16); }
#pragma unroll
                for (int k2 = 0; k2 < 2; ++k2) { const int ks = 2 * kh + k2;
                    const bf16x8 vfa = __builtin_bit_cast(bf16x8, ((u32x4){va0[k2].x, va0[k2].y, va1[k2].x, va1[k2].y})), vfc = __builtin_bit_cast(bf16x8, ((u32x4){vc0[k2].x, vc0[k2].y, vc1[k2].x, vc1[k2].y}));
                    oa0 = __builtin_amdgcn_mfma_f32_32x32x16_bf16(qa[ks], vfa, oa0, 0, 0, 0); oa1 = __builtin_amdgcn_mfma_f32_32x32x16_bf16(qa[ks], vfc, oa1, 0, 0, 0);
                    ob0 = __builtin_amdgcn_mfma_f32_32x32x16_bf16(qb4[ks], vfa, ob0, 0, 0, 0); ob1 = __builtin_amdgcn_mfma_f32_32x32x16_bf16(qb4[ks], vfc, ob1, 0, 0, 0); }
                __builtin_amdgcn_sched_barrier(0);
            }
        }
        if (t + 1 < nt) AT_STORE(bf ^ 1);
        __syncthreads();
    }
    if (act) {
        lsa += shx(lsa, 32, lane); lsb += shx(lsb, 32, lane);
        if (hi == 0) wsf[r32] = lsa;
        asm volatile("s_waitcnt lgkmcnt(0)" ::: "memory");
#pragma unroll
        for (int r = 0; r < 16; ++r) { const float rl = 1.f / wsf[crow(r, hi)]; bf16_t* op = Op + (size_t)(wid * 64 + crow(r, hi)) * 512;
            op[r32] = f2bf(oa0[r] * rl); op[32 + r32] = f2bf(oa1[r] * rl); }
        asm volatile("s_waitcnt lgkmcnt(0)" ::: "memory");
        if (hi == 0) wsf[r32] = lsb;
        asm volatile("s_waitcnt lgkmcnt(0)" ::: "memory");
#pragma unroll
        for (int r = 0; r < 16; ++r) { const float rl = 1.f / wsf[crow(r, hi)]; bf16_t* op = Op + (size_t)(wid * 64 + 32 + crow(r, hi)) * 512;
            op[r32] = f2bf(ob0[r] * rl); op[32 + r32] = f2bf(ob1[r] * rl); }
    }
    __syncthreads();
#undef AT_LOAD
#undef AT_STORE
#undef AT_SM
#undef MAX3
}
DI void phase_attn(ArgsP a, int tb_, bool with_ctx, char* shm, int vcu, int G) {
    const bf16_t* Qb = (const bf16_t*)(a->ws + A_Q); const bf16_t* Kb = (const bf16_t*)(a->ws + A_K); const bf16_t* Vt = (const bf16_t*)(a->ws + A_VT);
    bf16_t* oa = (bf16_t*)(a->ws + A_OA);
    const int nu = 512 + (with_ctx ? 64 : 0);
    for (int u = vcu; u < nu; u += G) {
        const bool lat = u < 512; const int bh = lat ? (u >> 3) : (u - 512), qb = lat ? (u & 7) : 0, b = bh >> 3, h = bh & 7;
        const bf16_t* Qp = Qb + ((size_t)bh * KVLEN + (lat ? LC + qb * 512 : 0)) * 96;
        bf16_t* Op = oa + (lat ? ((size_t)b * SEQ + qb * 512) : ((size_t)ML + b * LC)) * 512 + h * 64;
        attn_unit(tb_, shm, Qp, Kb + (size_t)bh * KVLEN * 96, Vt + (size_t)bh * 64 * KVLEN, lat ? KVLEN : LC, lat ? 512 : 256, Op);
    }
}

DI void phase_poolprep(ArgsP a, int tb_, int MR, int vcu, int G) {
    const bf16_t* zr = (const bf16_t*)(a->ws + A_ZR); bf16_t* pz = (bf16_t*)(a->ws + A_PZ);
    int tid_ = tb_ + lane_asm(); asm volatile("" : "+v"(tid_)); const int gt = vcu * NTHR + tid_, NGT = G * NTHR;
    for (int i = gt; i < MR * 64; i += NGT) {
        const int m = i >> 6, c8 = i & 63, w2 = 1 << (c8 >> 4);
        const bool lat = m < ML; const int t = lat ? (m & 4095) : ((m - ML) & 255), Ls = lat ? SEQ : LC, mb = m - t;
        const int lo = max(t - w2, 0), hi = min(t + w2, Ls);
        float s[8];
#pragma unroll
        for (int j = 0; j < 8; ++j) s[j] = 0.f;
        const int cnt = hi - lo; const bf16_t* zp = zr + (size_t)(mb + lo) * ZR + c8 * 8;
        u32x4 wv[16];
#pragma unroll
        for (int r = 0; r < 16; ++r) { wv[r] = (u32x4){0u, 0u, 0u, 0u}; if (r < cnt) wv[r] = *(const u32x4*)(zp + (size_t)r * ZR); }
#pragma unroll
        for (int r = 0; r < 16; ++r) { const u32x4 w = wv[r];
            s[0] += bflo(w.x); s[1] += bfhi(w.x); s[2] += bflo(w.y); s[3] += bfhi(w.y); s[4] += bflo(w.z); s[5] += bfhi(w.z); s[6] += bflo(w.w); s[7] += bfhi(w.w); }
        const u32x4 w = *(const u32x4*)(zr + (size_t)m * ZR + c8 * 8); const float inv = 1.f / (float)(hi - lo);
        u32x4 o; o.x = cvtpk(s[0] * inv - bflo(w.x), s[1] * inv - bfhi(w.x)); o.y = cvtpk(s[2] * inv - bflo(w.y), s[3] * inv - bfhi(w.y));
        o.z = cvtpk(s[4] * inv - bflo(w.z), s[5] * inv - bfhi(w.z)); o.w = cvtpk(s[6] * inv - bflo(w.w), s[7] * inv - bfhi(w.w));
        *(u32x4*)(pz + (size_t)m * 512 + c8 * 8) = o;
    }
}

DI float logsig(float x) { return fminf(x, 0.f) - __logf(1.f + __expf(-fabsf(x))); }
DI int gla_row0(int b, int dir, int s) { if (s < 4) { const int c = dir ? 3 - s : s; return ML + b * LC + 64 * c; } const int c = dir ? 67 - s : s - 4; return b * SEQ + 64 * c; }
DI float scan64(float x, int lane) {
#pragma unroll
    for (int off = 1; off < 64; off <<= 1) { const float y = __int_as_float(__builtin_amdgcn_ds_bpermute((lane - off) << 2, __float_as_int(x))); if (lane >= off) x += y; }
    return x;
}
DI bf16x8 gla_wfrag(const float* w, int col, int hi) {
    u32x4 p; const float* q = w + (size_t)(8 * hi) * 256 + col;
    p.x = cvtpk(q[0], q[256]); p.y = cvtpk(q[512], q[768]); p.z = cvtpk(q[1024], q[1280]); p.w = cvtpk(q[1536], q[1792]);
    return __builtin_bit_cast(bf16x8, p);
}
DI void phase_gla1(ArgsP a, int tb_, int l, char* shm, int vcu, int G) {
    int tid_ = tb_ + lane_asm(); asm volatile("" : "+v"(tid_)); const int tid = tid_, lane = tid & 63, r32 = lane & 31, hi = lane >> 5, wid = tid >> 6;
    const bf16_t* zr = (const bf16_t*)(a->ws + A_ZR); bf16_t* ST = (bf16_t*)(a->ws + A_ST); float* DEC = (float*)(a->ws + A_DEC);
    float* LA = (float*)shm; char* KT = shm + 16640; char* VT = shm + 25856;
    for (int scan = vcu >> 2; scan < 64; scan += (G >> 2)) {
        const int dir = scan & 1, h = (scan >> 1) & 3, b = scan >> 3;
        const float* wa2 = a->in[I_WA2] + ((size_t)l * 2 + dir) * 16 * 256 + h * 64; const float* ba2 = a->in[I_BA2] + ((size_t)l * 2 + dir) * 256 + h * 64;
        const int jb = (wid >> 1) & 1, kb = wid & 1;
        const bf16x8 wfr = gla_wfrag(wa2, kb * 32 + r32, hi); const float bias = ba2[kb * 32 + r32];
        const int j = tid >> 3, kg = tid & 7, jl = dir ? 0 : 63;
#define GLA1_LOAD(S_, G_, K_, V0_, V1_) do { const int m0_ = gla_row0(b, dir, (S_)); G_ = *(const bf16x8*)(zr + (size_t)(m0_ + jb * 32 + r32) * ZR + 2048 + dir * 16 + 8 * hi); \
            K_ = *(const u32x4*)(zr + (size_t)(m0_ + j) * ZR + 768 + h * 64 + kg * 8); const u32x4* vp_ = (const u32x4*)(zr + (size_t)(m0_ + j) * ZR + 1024 + h * 128 + kg * 16); V0_ = vp_[0]; V1_ = vp_[1]; } while (0)
        bf16x8 ngfr; u32x4 nkw, nv0, nv1;
        GLA1_LOAD(vcu & 3, ngfr, nkw, nv0, nv1);
        for (int s = vcu & 3; s < NSLOT; s += 4) {
            const int item = scan * NSLOT + s;
            const bf16x8 gfr = ngfr; const u32x4 kw = nkw, v0 = nv0, v1 = nv1;
            if (s + 4 < NSLOT) GLA1_LOAD(s + 4, ngfr, nkw, nv0, nv1);
            if (wid < 4) { f32x16 acc;
#pragma unroll
                for (int r = 0; r < 16; ++r) acc[r] = 0.f;
                acc = __builtin_amdgcn_mfma_f32_32x32x16_bf16(gfr, wfr, acc, 0, 0, 0);
#pragma unroll
                for (int r = 0; r < 16; ++r) LA[(jb * 32 + crow(r, hi)) * 65 + kb * 32 + r32] = logsig(acc[r] + bias) * (1.f / 16.f); }
            __syncthreads();
#pragma unroll
            for (int i = 0; i < 8; ++i) { const int kd = wid * 8 + i, jj = dir ? 63 - lane : lane; const float x = scan64(LA[jj * 65 + kd], lane); LA[jj * 65 + kd] = x; }
            __syncthreads();
            { const float kv[8] = {bflo(kw.x), bfhi(kw.x), bflo(kw.y), bfhi(kw.y), bflo(kw.z), bfhi(kw.z), bflo(kw.w), bfhi(kw.w)};
#pragma unroll
              for (int kk = 0; kk < 8; ++kk) { const int kd = kg * 8 + kk; *(bf16_t*)(KT + kd * 144 + j * 2) = f2bf(kv[kk] * __expf(LA[jl * 65 + kd] - LA[j * 65 + kd])); }
              const unsigned vv[8] = {v0.x, v0.y, v0.z, v0.w, v1.x, v1.y, v1.z, v1.w};
#pragma unroll
              for (int q = 0; q < 8; ++q) { *(bf16_t*)(VT + (kg * 16 + 2 * q) * 144 + j * 2) = (bf16_t)(vv[q] & 0xffffu); *(bf16_t*)(VT + (kg * 16 + 2 * q + 1) * 144 + j * 2) = (bf16_t)(vv[q] >> 16); } }
            if (tid < 64) DEC[(size_t)item * 64 + tid] = __expf(LA[jl * 65 + tid]);
            __syncthreads();
            { const int kdb = wid >> 2, vb = wid & 3; f32x16 acc;
#pragma unroll
              for (int r = 0; r < 16; ++r) acc[r] = 0.f;
#pragma unroll
              for (int s4 = 0; s4 < 4; ++s4) { const bf16x8 af = *(const bf16x8*)(KT + (kdb * 32 + r32) * 144 + (16 * s4 + 8 * hi) * 2); const bf16x8 bfr = *(const bf16x8*)(VT + (vb * 32 + r32) * 144 + (16 * s4 + 8 * hi) * 2);
                  acc = __builtin_amdgcn_mfma_f32_32x32x16_bf16(af, bfr, acc, 0, 0, 0); }
              bf16_t* sp = ST + (size_t)item * 8192 + (size_t)(vb * 32 + r32) * 64 + kdb * 32 + 4 * hi;
#pragma unroll
              for (int g4 = 0; g4 < 4; ++g4) { u32x2 w; w.x = cvtpk(acc[4 * g4], acc[4 * g4 + 1]); w.y = cvtpk(acc[4 * g4 + 2], acc[4 * g4 + 3]); *(u32x2*)(sp + 8 * g4) = w; } }
        }
        __syncthreads();
    }
}
DI void phase_gla2(ArgsP a, int tb_, int vcu, int G) {
    bf16_t* ST = (bf16_t*)(a->ws + A_ST); const float* DEC = (const float*)(a->ws + A_DEC);
    int tid_ = tb_ + lane_asm(); asm volatile("" : "+v"(tid_)); const int gt = vcu * NTHR + tid_, NGT = G * NTHR;
    for (int e = gt; e < 64 * 128 * 16; e += NGT) {
        const int kd4 = e & 15, v = (e >> 4) & 127, scan = e >> 11;
        bf16_t* sp = ST + (size_t)scan * NSLOT * 8192 + v * 64 + kd4 * 4; const float* dp = DEC + (size_t)scan * NSLOT * 64 + kd4 * 4;
        float S0 = 0.f, S1 = 0.f, S2 = 0.f, S3 = 0.f;
        u32x2 dcur[4]; f32x4 ccur[4];
#pragma unroll
        for (int i = 0; i < 4; ++i) { dcur[i] = *(const u32x2*)(sp + (size_t)i * 8192); ccur[i] = *(const f32x4*)(dp + i * 64); }
        for (int g = 0; g < NSLOT / 4; ++g) {
            u32x2 dn[4]; f32x4 cn[4];
            if (g + 1 < NSLOT / 4) {
#pragma unroll
                for (int i = 0; i < 4; ++i) { dn[i] = *(const u32x2*)(sp + (size_t)(4 * g + 4 + i) * 8192); cn[i] = *(const f32x4*)(dp + (4 * g + 4 + i) * 64); } }
            else {
#pragma unroll
                for (int i = 0; i < 4; ++i) { dn[i] = dcur[i]; cn[i] = ccur[i]; } }
#pragma unroll
            for (int i = 0; i < 4; ++i) { u32x2 w; w.x = cvtpk(S0, S1); w.y = cvtpk(S2, S3); *(u32x2*)(sp + (size_t)(4 * g + i) * 8192) = w;
                S0 = ccur[i].x * S0 + bflo(dcur[i].x); S1 = ccur[i].y * S1 + bfhi(dcur[i].x); S2 = ccur[i].z * S2 + bflo(dcur[i].y); S3 = ccur[i].w * S3 + bfhi(dcur[i].y); }
#pragma unroll
            for (int i = 0; i < 4; ++i) { dcur[i] = dn[i]; ccur[i] = cn[i]; }
        }
    }
}
DI void phase_gla3(ArgsP a, int tb_, int l, bool with_ctx, char* shm, int vcu, int G) {
    int tid_ = tb_ + lane_asm(); asm volatile("" : "+v"(tid_)); const int tid = tid_, lane = tid & 63, r32 = lane & 31, hi = lane >> 5, wid = tid >> 6;
    const bf16_t* zr = (const bf16_t*)(a->ws + A_ZR); const bf16_t* ST = (const bf16_t*)(a->ws + A_ST); bf16_t* og = (bf16_t*)(a->ws + A_OG);
    float* LA = (float*)shm; char* QT = shm + 33792; char* KTt = shm + 52224; char* VT = shm + 70656; char* AM = shm + 89088; float* OS = (float*)shm;
    const float* ggl = a->in[I_GGLA] + l * 128;
    for (int bh = vcu >> 3; bh < 32; bh += (G >> 3)) {
        const int h = bh & 3, b = bh >> 2;
        const int ldir = wid >> 2, ljb = (wid >> 1) & 1, lkb = wid & 1;
        const float* wa2 = a->in[I_WA2] + ((size_t)l * 2 + ldir) * 16 * 256 + h * 64; const float* ba2 = a->in[I_BA2] + ((size_t)l * 2 + ldir) * 256 + h * 64;
        const bf16x8 wfr = gla_wfrag(wa2, lkb * 32 + r32, hi); const float bias = ba2[lkb * 32 + r32];
        const int j = tid >> 3, kg = tid & 7;
#define GLA3_M0(P_) ((P_) < 4 ? ML + b * LC + 64 * (P_) : b * SEQ + 64 * ((P_) - 4))
#define GLA3_LOAD(P_, G_, Q_, K_, V0_, V1_) do { const int m0_ = GLA3_M0(P_); G_ = *(const bf16x8*)(zr + (size_t)(m0_ + ljb * 32 + r32) * ZR + 2048 + ldir * 16 + 8 * hi); \
            Q_ = *(const u32x4*)(zr + (size_t)(m0_ + j) * ZR + 512 + h * 64 + kg * 8); K_ = *(const u32x4*)(zr + (size_t)(m0_ + j) * ZR + 768 + h * 64 + kg * 8); \
            const u32x4* vp_ = (const u32x4*)(zr + (size_t)(m0_ + j) * ZR + 1024 + h * 128 + kg * 16); V0_ = vp_[0]; V1_ = vp_[1]; } while (0)
        int pst = vcu & 7; if (pst < 4 && !with_ctx) pst += 8;
        bf16x8 ngfr; u32x4 nqw, nkw, nv0, nv1;
        GLA3_LOAD(pst, ngfr, nqw, nkw, nv0, nv1);
        for (int p = pst; p < NSLOT; p += 8) {
            const int m0 = GLA3_M0(p);
            const int slot_f = p, slot_b = p < 4 ? 3 - p : 71 - p;
            const bf16x8 gfr = ngfr; const u32x4 qw = nqw, kw = nkw, v0 = nv0, v1 = nv1;
            if (p + 8 < NSLOT) GLA3_LOAD(p + 8, ngfr, nqw, nkw, nv0, nv1);
            { f32x16 acc;
#pragma unroll
              for (int r = 0; r < 16; ++r) acc[r] = 0.f;
              acc = __builtin_amdgcn_mfma_f32_32x32x16_bf16(gfr, wfr, acc, 0, 0, 0);
#pragma unroll
              for (int r = 0; r < 16; ++r) LA[ldir * 4160 + (ljb * 32 + crow(r, hi)) * 65 + lkb * 32 + r32] = logsig(acc[r] + bias) * (1.f / 16.f); }
            __syncthreads();
            { const int dir = wid >> 2;
#pragma unroll
              for (int i = 0; i < 16; ++i) { const int kd = (wid & 3) * 16 + i, jj = dir ? 63 - lane : lane; const float x = scan64(LA[dir * 4160 + jj * 65 + kd], lane); LA[dir * 4160 + jj * 65 + kd] = x; } }
            __syncthreads();
            { const float qv[8] = {bflo(qw.x), bfhi(qw.x), bflo(qw.y), bfhi(qw.y), bflo(qw.z), bfhi(qw.z), bflo(qw.w), bfhi(qw.w)};
              const float kv[8] = {bflo(kw.x), bfhi(kw.x), bflo(kw.y), bfhi(kw.y), bflo(kw.z), bfhi(kw.z), bflo(kw.w), bfhi(kw.w)};
#pragma unroll
              for (int dir = 0; dir < 2; ++dir) { float qt[8], kt[8];
#pragma unroll
                  for (int kk = 0; kk < 8; ++kk) { const float e = LA[dir * 4160 + j * 65 + kg * 8 + kk]; qt[kk] = qv[kk] * 0.125f * __expf(e); kt[kk] = kv[kk] * __expf(-e); }
                  u32x4 w; w.x = cvtpk(qt[0], qt[1]); w.y = cvtpk(qt[2], qt[3]); w.z = cvtpk(qt[4], qt[5]); w.w = cvtpk(qt[6], qt[7]); *(u32x4*)(QT + dir * 9216 + j * 144 + kg * 16) = w;
                  u32x4 w2; w2.x = cvtpk(kt[0], kt[1]); w2.y = cvtpk(kt[2], kt[3]); w2.z = cvtpk(kt[4], kt[5]); w2.w = cvtpk(kt[6], kt[7]); *(u32x4*)(KTt + dir * 9216 + j * 144 + kg * 16) = w2; }
              const unsigned vv[8] = {v0.x, v0.y, v0.z, v0.w, v1.x, v1.y, v1.z, v1.w};
#pragma unroll
              for (int q = 0; q < 8; ++q) { *(bf16_t*)(VT + (kg * 16 + 2 * q) * 144 + j * 2) = (bf16_t)(vv[q] & 0xffffu); *(bf16_t*)(VT + (kg * 16 + 2 * q + 1) * 144 + j * 2) = (bf16_t)(vv[q] >> 16); } }
            const u32x4* rp = (const u32x4*)(zr + (size_t)(m0 + j) * ZR + 1536 + h * 128 + kg * 16); const u32x4 r0 = rp[0], r1 = rp[1];
            const int oib = wid >> 2, ovb = wid & 3;
            bf16x8 sfr[2][4];
#pragma unroll
            for (int dir = 0; dir < 2; ++dir) { const bf16_t* sp = ST + ((size_t)((b * 4 + h) * 2 + dir) * NSLOT + (dir ? slot_b : slot_f)) * 8192 + (size_t)(ovb * 32 + r32) * 64 + 8 * hi;
#pragma unroll
                for (int s4 = 0; s4 < 4; ++s4) sfr[dir][s4] = *(const bf16x8*)(sp + 16 * s4); }
            __syncthreads();
            { const int dir = wid >> 2, ib = (wid >> 1) & 1, jb = wid & 1; f32x16 acc;
#pragma unroll
              for (int r = 0; r < 16; ++r) acc[r] = 0.f;
#pragma unroll
              for (int s4 = 0; s4 < 4; ++s4) { const bf16x8 af = *(const bf16x8*)(QT + dir * 9216 + (ib * 32 + r32) * 144 + (16 * s4 + 8 * hi) * 2); const bf16x8 bfr = *(const bf16x8*)(KTt + dir * 9216 + (jb * 32 + r32) * 144 + (16 * s4 + 8 * hi) * 2);
                  acc = __builtin_amdgcn_mfma_f32_32x32x16_bf16(af, bfr, acc, 0, 0, 0); }
              const int jc = jb * 32 + r32;
#pragma unroll
              for (int r = 0; r < 16; ++r) { const int ir = ib * 32 + crow(r, hi); const bool keep = dir ? (jc >= ir) : (jc <= ir); *(bf16_t*)(AM + dir * 9216 + ir * 144 + jc * 2) = f2bf(keep ? acc[r] : 0.f); } }
            __syncthreads();
            { f32x16 acc;
#pragma unroll
              for (int r = 0; r < 16; ++r) acc[r] = 0.f;
#pragma unroll
              for (int dir = 0; dir < 2; ++dir) {
#pragma unroll
                  for (int s4 = 0; s4 < 4; ++s4) { const bf16x8 af = *(const bf16x8*)(AM + dir * 9216 + (oib * 32 + r32) * 144 + (16 * s4 + 8 * hi) * 2); const bf16x8 bfr = *(const bf16x8*)(VT + (ovb * 32 + r32) * 144 + (16 * s4 + 8 * hi) * 2);
                      acc = __builtin_amdgcn_mfma_f32_32x32x16_bf16(af, bfr, acc, 0, 0, 0); }
#pragma unroll
                  for (int s4 = 0; s4 < 4; ++s4) { const bf16x8 af = *(const bf16x8*)(QT + dir * 9216 + (oib * 32 + r32) * 144 + (16 * s4 + 8 * hi) * 2);
                      acc = __builtin_amdgcn_mfma_f32_32x32x16_bf16(af, sfr[dir][s4], acc, 0, 0, 0); } }
#pragma unroll
              for (int r = 0; r < 16; ++r) OS[(oib * 32 + crow(r, hi)) * 132 + ovb * 32 + r32] = acc[r]; }
            __syncthreads();
            { const int i = j, vg = kg; float o[16]; float ss = 0.f;
#pragma unroll
              for (int q = 0; q < 4; ++q) { const f32x4 t4 = *(const f32x4*)(OS + i * 132 + vg * 16 + 4 * q); o[4 * q] = t4.x; o[4 * q + 1] = t4.y; o[4 * q + 2] = t4.z; o[4 * q + 3] = t4.w; ss += (t4.x * t4.x + t4.y * t4.y) + (t4.z * t4.z + t4.w * t4.w); }
              ss += shx(ss, 1, lane); ss += shx(ss, 2, lane); ss += shx(ss, 4, lane);
              const float rn = rsqrtf(ss * (1.f / 128.f) + EPS);
              const float gr[16] = {bflo(r0.x), bfhi(r0.x), bflo(r0.y), bfhi(r0.y), bflo(r0.z), bfhi(r0.z), bflo(r0.w), bfhi(r0.w), bflo(r1.x), bfhi(r1.x), bflo(r1.y), bfhi(r1.y), bflo(r1.z), bfhi(r1.z), bflo(r1.w), bfhi(r1.w)};
              float y[16];
#pragma unroll
              for (int q = 0; q < 16; ++q) y[q] = o[q] * rn * ggl[vg * 16 + q] * silu_f(gr[q]);
              u32x4 w0, w1; w0.x = cvtpk(y[0], y[1]); w0.y = cvtpk(y[2], y[3]); w0.z = cvtpk(y[4], y[5]); w0.w = cvtpk(y[6], y[7]); w1.x = cvtpk(y[8], y[9]); w1.y = cvtpk(y[10], y[11]); w1.z = cvtpk(y[12], y[13]); w1.w = cvtpk(y[14], y[15]);
              u32x4* op = (u32x4*)(og + (size_t)(m0 + i) * 512 + h * 128 + vg * 16); op[0] = w0; op[1] = w1; }
            __syncthreads();
        }
    }
}

#define XB_TMO      128
#define XB_XCNT(j)  (256  + 64 * (j))
#define XB_XSUB(j)  (1280 + 64 * (j))
#define XB_XGEN(j)  (2304 + 64 * (j))
#define XB_TOP      3328
#define XB_TOPGEN   3392
#define XCD_BAR_WORDS 3456
#define XB_SPIN_CAP (1u << 18)
DI unsigned xb_ld(unsigned* p)              { return __hip_atomic_load(p, __ATOMIC_RELAXED, __HIP_MEMORY_SCOPE_AGENT); }
DI unsigned xb_add(unsigned* p, unsigned v) { return __hip_atomic_fetch_add(p, v, __ATOMIC_RELAXED, __HIP_MEMORY_SCOPE_AGENT); }
DI unsigned xb_xcc_id() { return (unsigned)__builtin_amdgcn_s_getreg((3 << 11) | 20) & 0xFu; }
#define XB_SPIN(cond, bar) do { unsigned _sp = 0; while (cond) { __builtin_amdgcn_s_sleep(1); \
    if ((++_sp & 255u) == 0u) { if (xb_ld(&(bar)[XB_TMO])) break; if (_sp > XB_SPIN_CAP) { atomicAdd(&(bar)[XB_TMO], 1u); break; } } } } while (0)
struct XcdBarrier { unsigned* bar; unsigned x; volatile LAS unsigned* st; };
DI XcdBarrier xcd_barrier_post(unsigned* bar, volatile LAS unsigned* st) {
    XcdBarrier b; b.bar = bar; b.x = xb_xcc_id(); b.st = st;
    if (threadIdx.x == 0) (void)xb_add(&bar[XB_XCNT(b.x)], 1u);
    return b;
}
DI void xcd_barrier_complete(unsigned* bar, unsigned x, unsigned& nloc, unsigned& nx) {
    const unsigned G = gridDim.x * gridDim.y * gridDim.z;
    unsigned sum, cnt, mine, sp = 0u;
    for (;;) {
        sum = 0u; cnt = 0u; mine = 0u;
#pragma unroll 1
        for (unsigned j = 0; j < 16; ++j) { const unsigned c = xb_ld(&bar[XB_XCNT(j)]); sum += c; cnt += (c > 0u) ? 1u : 0u; mine = (j == x) ? c : mine; }
        if (sum == G) break;
        __builtin_amdgcn_s_sleep(1);
        if ((++sp & 255u) == 0u) { if (xb_ld(&bar[XB_TMO])) break; if (sp > XB_SPIN_CAP) { atomicAdd(&bar[XB_TMO], 1u); break; } }
    }
    nloc = mine > 0u ? mine : 1u; nx = cnt > 0u ? cnt : 1u;
}
DI void xcd_barrier(const XcdBarrier& b, int tb_) {
    asm volatile("s_waitcnt vmcnt(0)" ::: "memory");
    __syncthreads();
    if (tb_ == 0 && lane_asm() == 0) {
        unsigned* bar = b.bar; unsigned bx_ = b.x; asm volatile("" : "+s"(bar), "+s"(bx_));
        __builtin_amdgcn_s_waitcnt(0);
        unsigned nloc = b.st[0], nx = b.st[1];
        if (nloc == 0u) { xcd_barrier_complete(bar, bx_, nloc, nx); b.st[0] = nloc; b.st[1] = nx; }
        const unsigned old = xb_add(&bar[XB_XSUB(bx_)], 1u);
        const unsigned gen = old / nloc;
        if (old + 1u == (gen + 1u) * nloc) {
            __builtin_amdgcn_fence(__ATOMIC_RELEASE, "agent");
            asm volatile("s_waitcnt vmcnt(0)" ::: "memory");
            const unsigned og = xb_add(&bar[XB_TOP], 1u);
            const unsigned tg = og / nx;
            if (og + 1u == (tg + 1u) * nx) xb_add(&bar[XB_TOPGEN], 1u);
            else XB_SPIN(xb_ld(&bar[XB_TOPGEN]) == tg, bar);
            __builtin_amdgcn_fence(__ATOMIC_ACQUIRE, "agent");
            xb_add(&bar[XB_XGEN(bx_)], 1u);
            asm volatile("s_waitcnt vmcnt(0)" ::: "memory");
        } else {
            XB_SPIN(xb_ld(&bar[XB_XGEN(bx_)]) == gen, bar);
            __builtin_amdgcn_fence(__ATOMIC_ACQUIRE, "agent");
            asm volatile("s_waitcnt vmcnt(0)" ::: "memory");
        }
    }
    __syncthreads();
}

__global__ void __launch_bounds__(NTHR, 2) mk_fwd(Args a_unused) {
    extern __shared__ __attribute__((aligned(16))) unsigned char lds[];
    cg::grid_group grid = cg::this_grid();
    char* shm = (char*)lds; LAS unsigned char* lds3 = (LAS unsigned char*)lds;
    const int tb_ = __builtin_amdgcn_readfirstlane((int)(threadIdx.x & ~63u));
    volatile LAS unsigned* bst = (volatile LAS unsigned*)(lds3 + 131072 + 64);
    if (threadIdx.x == 0) { bst[0] = 0u; bst[1] = 0u; }
    __syncthreads();
    const XcdBarrier bar = xcd_barrier_post((unsigned*)(a_unused.ws + WS_BAR), bst);
    if (a_unused.ph_hi < 0) grid.sync();
    int ph = 0;
#define PH_BEGIN { int G = gridDim.x, bx = blockIdx.x; asm volatile("" : "+s"(G), "+s"(bx)); const int vcu = (G % 8 == 0) ? (bx % 8) * (G / 8) + bx / 8 : bx; (void)vcu; ArgsP a = (ArgsP)__builtin_amdgcn_kernarg_segment_ptr(); asm volatile("" : "+s"(a)); unsigned char* ws = a->ws; bf16_t* U = (bf16_t*)(ws + WS_U); float* hc = (float*)(ws + WS_HC); unsigned char* W = ws + WS_W; \
    const float* modl = (const float*)(ws + WS_MOD) + (size_t)l * 9 * (NMOD * D); (void)U; (void)hc; (void)W; (void)modl;
#define PH_END(last) if (!(last)) { for (int r_ = 0; r_ < REPN(15); ++r_) { xcd_barrier(bar, tb_); } } } ++ph;

    for (int l = 0; l < 2; ++l) {
        const int MR = l == 0 ? M : ML;
        PH_BEGIN if (l == 0) phase_mod(a, tb_, shm, vcu, G); else phase_normmod(a, tb_, l, 0, false, true, false, M, vcu, G); __syncthreads(); phase_convert(a, tb_, l, shm, vcu, G); PH_END(false)
        if (l == 0) { PH_BEGIN phase_normmod(a, tb_, l, 0, true, false, false, M, vcu, G); PH_END(false) }
        PH_BEGIN { pg8::Gemm g{U, U, U, (const bf16_t*)(W + W_13A), (const bf16_t*)(W + W_13A), (const bf16_t*)(W + W_13A), D}; pg8::Sched S; S.init(M, 2 * DFF, D, G, bx);
            pg8::EpiFfn13 E{(bf16_t*)(ws + A_G)}; for (int r_ = 0; r_ < REPN(7); ++r_) pg8::gemm_phase<pg8::EpiFfn13>(tb_, lds3, g, S, E); } PH_END(false)
        PH_BEGIN { const bf16_t* A = (const bf16_t*)(ws + A_G); const bf16_t* B = (const bf16_t*)(W + W_2A); pg8::Gemm g{A, A, A, B, B, B, DFF}; pg8::Sched S; S.init(M, D, DFF, G, bx, 1 << 30, 1, 1);
            const float* bl = a->out; if (l == 0) bl = a->in[I_X]; pg8::EpiResid E{a->out, ws, bl, l, 2, 0.5f}; pg8::gemm_phase<pg8::EpiResid>(tb_, lds3, g, S, E); } PH_END(false)
        PH_BEGIN for (int r_ = 0; r_ < REPN(5); ++r_) phase_normmod(a, tb_, l, 1, false, true, l == 0, M, vcu, G); PH_END(false)
        PH_BEGIN { const bf16_t* B = (const bf16_t*)(W + W_IN); pg8::Gemm g{U, U, U, B, B + (size_t)256 * D, B, D}; pg8::Sched S; S.init(M, 512, D, G, bx, 1);
            pg8::EpiStore<0> E{(bf16_t*)(ws + A_ZCQ), (bf16_t*)(ws + A_ZKV), 256, 256, 0, 0}; pg8::gemm_phase<pg8::EpiStore<0>>(tb_, lds3, g, S, E); } PH_END(false)
        PH_BEGIN { const bf16_t* A0 = (const bf16_t*)(ws + A_ZCQ); const bf16_t* A1 = (const bf16_t*)(ws + A_ZKV); pg8::Gemm g{A0, A1, A0, (const bf16_t*)(W + W_UQ), (const bf16_t*)(W + W_UKV), (const bf16_t*)(W + W_UQ), 256};
            pg8::Sched S; S.init(M, 768 + 1024, 256, G, bx, 3);
            pg8::EpiStore<0> E{(bf16_t*)(ws + A_QRAW), (bf16_t*)(ws + A_KVRAW), 768, 1024, 0, 0}; pg8::gemm_phase<pg8::EpiStore<0>>(tb_, lds3, g, S, E); } PH_END(false)
        PH_BEGIN for (int r_ = 0; r_ < REPN(1); ++r_) phase_mla_fin(a, tb_, l, shm, vcu, G); PH_END(false)
        PH_BEGIN for (int r_ = 0; r_ < REPN(0); ++r_) phase_attn(a, tb_, l == 0, shm, vcu, G); PH_END(false)
        PH_BEGIN { const bf16_t* B = (const bf16_t*)(W + W_IN) + (size_t)512 * D; pg8::Gemm g{U, U, U, B, B, B, D}; pg8::Sched S; S.init(M, ZR, D, G, bx);
            pg8::EpiStore<0> E{(bf16_t*)(ws + A_ZR), (bf16_t*)(ws + A_ZR), ZR, ZR, 0, 0}; pg8::gemm_phase<pg8::EpiStore<0>>(tb_, lds3, g, S, E); } PH_END(false)
        PH_BEGIN for (int r_ = 0; r_ < REPN(2); ++r_) phase_poolprep(a, tb_, MR, vcu, G); for (int r_ = 0; r_ < REPN(3); ++r_) phase_gla1(a, tb_, l, shm, vcu, G); PH_END(false)
        PH_BEGIN phase_gla2(a, tb_, vcu, G); __syncthreads();
            { const bf16_t* A = (const bf16_t*)(ws + A_PZ); const bf16_t* B = (const bf16_t*)(W + W_POOL); pg8::Gemm g{A, A, A, B, B, B, 512}; pg8::Sched S; S.init(MR, 512, 512, G, bx);
              pg8::EpiStore<0> E{(bf16_t*)(ws + A_OP), (bf16_t*)(ws + A_OP), 512, 512, 0, 0}; pg8::gemm_phase<pg8::EpiStore<0>>(tb_, lds3, g, S, E); } PH_END(false)
        PH_BEGIN for (int r_ = 0; r_ < REPN(4); ++r_) phase_gla3(a, tb_, l, l == 0, shm, vcu, G); PH_END(false)
        PH_BEGIN { const bf16_t* B = (const bf16_t*)(W + W_IN) + (size_t)2816 * D; pg8::Gemm g{U, U, U, B, B, B, D}; pg8::Sched S; S.init(MR, 3072, D, G, bx);
            pg8::EpiStore<2> E{(bf16_t*)(ws + A_GATES), (bf16_t*)(ws + A_GATES), D, D, 1024, (size_t)M * D}; for (int r_ = 0; r_ < REPN(10); ++r_) pg8::gemm_phase<pg8::EpiStore<2>>(tb_, lds3, g, S, E); } PH_END(false)
        PH_BEGIN { const bf16_t* B = (const bf16_t*)(W + W_BR); pg8::Gemm g{(const bf16_t*)(ws + A_OA), (const bf16_t*)(ws + A_OP), (const bf16_t*)(ws + A_OG), B, B + (size_t)1024 * 512, B + (size_t)2 * 1024 * 512, 512};
            pg8::Sched S; S.init(MR, D, 512, G, bx, 1 << 30, 3);
            pg8::EpiMerge E{(const bf16_t*)(ws + A_GATES), (bf16_t*)(ws + A_MM)}; for (int r_ = 0; r_ < REPN(11); ++r_) pg8::gemm_phase<pg8::EpiMerge>(tb_, lds3, g, S, E); } PH_END(false)
        PH_BEGIN { const bf16_t* A = (const bf16_t*)(ws + A_MM); const bf16_t* B = (const bf16_t*)(W + W_OUT); pg8::Gemm g{A, A, A, B, B, B, D}; pg8::Sched S; S.init(MR, D, D, G, bx, 1 << 30, 1, 1);
            pg8::EpiResid E{a->out, ws, a->out, l, 5, 1.0f}; pg8::gemm_phase<pg8::EpiResid>(tb_, lds3, g, S, E); } PH_END(false)
        PH_BEGIN phase_normmod(a, tb_, l, 2, false, l == 0, false, MR, vcu, G); PH_END(false)
        PH_BEGIN { pg8::Gemm g{U, U, U, (const bf16_t*)(W + W_13B), (const bf16_t*)(W + W_13B), (const bf16_t*)(W + W_13B), D}; pg8::Sched S; S.init(MR, 2 * DFF, D, G, bx);
            pg8::EpiFfn13 E{(bf16_t*)(ws + A_G)}; for (int r_ = 0; r_ < REPN(7); ++r_) pg8::gemm_phase<pg8::EpiFfn13>(tb_, lds3, g, S, E); } PH_END(false)
        PH_BEGIN { const bf16_t* A = (const bf16_t*)(ws + A_G); const bf16_t* B = (const bf16_t*)(W + W_2B); pg8::Gemm g{A, A, A, B, B, B, DFF}; pg8::Sched S; S.init(MR, D, DFF, G, bx, 1 << 30, 1, 1);
            pg8::EpiResid E{a->out, ws, a->out, l, 8, 0.5f}; pg8::gemm_phase<pg8::EpiResid>(tb_, lds3, g, S, E); } PH_END(l == 1)
    }
}

extern "C" void kernel_launch(void* const* d_in, const int* in_sizes, int n_in, void* d_out, int out_size, void* d_ws, size_t ws_size, hipStream_t stream) {
    static int grid = 0;
    if (grid == 0) {
        if (n_in != 29 || out_size != ML * D || ws_size < WS_NEED) { fprintf(stderr, "kernel_launch: unexpected shapes: n_in %d out %d ws %zu (need %zu)\n", n_in, out_size, ws_size, (size_t)WS_NEED); grid = -1; return; }
        int dev = 0, cus = 0, per_cu = 0;
        hipGetDevice(&dev); hipDeviceGetAttribute(&cus, hipDeviceAttributeMultiprocessorCount, dev);
        if (hipFuncSetAttribute((const void*)mk_fwd, hipFuncAttributeMaxDynamicSharedMemorySize, LDS_BYTES) != hipSuccess) { fprintf(stderr, "kernel_launch: hipFuncSetAttribute failed\n"); grid = -1; return; }
        if (hipOccupancyMaxActiveBlocksPerMultiprocessor(&per_cu, (const void*)mk_fwd, NTHR, LDS_BYTES) != hipSuccess || per_cu < 1) { fprintf(stderr, "kernel_launch: occupancy query says %d\n", per_cu); per_cu = 1; }
        (void)hipGetLastError();
        grid = cus;
    }
    if (grid < 0) return;
    if (hipMemsetAsync((char*)d_ws + WS_BAR, 0, 16384, stream) != hipSuccess) { fprintf(stderr, "kernel_launch: memset failed\n"); return; }
    Args a{};
    for (int i = 0; i < 29; ++i) a.in[i] = (const float*)d_in[i];
    a.out = (float*)d_out; a.ws = (unsigned char*)d_ws; a.ph_lo = 0; a.ph_hi = 1000;
    void* args[] = {&a};
    hipError_t e = hipLaunchCooperativeKernel((const void*)mk_fwd, dim3(grid), dim3(NTHR), args, LDS_BYTES, stream);
    if (e != hipSuccess) fprintf(stderr, "cooperative launch failed: %s (grid %d)\n", hipGetErrorString(e), grid);
}
```
